# Optimizing an MI355X kernel written in HIP

```python
import math
import jax, jax.numpy as jnp
from jax import lax
import numpy as np

D_MODEL = 1024
BATCH = 2
SEQ = 8192
DEPTH = 1

ATTN_HEADS = 8
ATTN_HEAD_DIM = 64
ATTN_V_DIM = 2 * ATTN_HEAD_DIM
ATTN_QK_WIDTH = ATTN_HEADS * 2 * ATTN_HEAD_DIM
ATTN_V_WIDTH = ATTN_HEADS * ATTN_V_DIM
ROPE_THETA = 10000.0
Q_BLOCK = 128
SSD_D_INNER = 2 * D_MODEL
SSD_HEAD_DIM = 64
SSD_HEADS = SSD_D_INNER // SSD_HEAD_DIM
SSD_GROUPS = 4
SSD_HEADS_PER_GROUP = SSD_HEADS // SSD_GROUPS
SSD_D_STATE = 128
SSD_CONV = 4
SSD_CHUNK = 128
SSD_CONV_DIM = SSD_D_INNER + 2 * SSD_GROUPS * SSD_D_STATE
IN_SIZES = (ATTN_QK_WIDTH, ATTN_QK_WIDTH, ATTN_V_WIDTH, D_MODEL, D_MODEL, SSD_D_INNER, SSD_CONV_DIM, SSD_HEADS)
IN_WIDTH = ATTN_QK_WIDTH * 2 + ATTN_V_WIDTH + 2 * D_MODEL + SSD_D_INNER + SSD_CONV_DIM + SSD_HEADS
N_EXPERTS = 64
TOP_K = 8
N_EXPERT_GROUPS = 8
TOPK_GROUPS = 4
EXPERT_DIM = 256
SHARED_DIM = 256
ROUTED_SCALE = 2.5
MOE_TOKEN_BLOCK = 128
EPS = 1e-6

kernel_name = "hybrid_diffattn_ssd_moe_adaln"


def rmsnorm(x, g):
    x32 = x.astype(jnp.float32)
    r = x32 * lax.rsqrt(jnp.mean(x32 * x32, axis=-1, keepdims=True) + EPS)
    return (r * g.astype(jnp.float32)).astype(x.dtype)


def rope(x, positions):
    d = x.shape[-1]
    half = d // 2
    inv_freq = ROPE_THETA ** (-jnp.arange(half, dtype=jnp.float32) * 2.0 / d)
    ang = positions.astype(jnp.float32)[..., None] * inv_freq
    ang = ang.reshape(ang.shape[:2] + (1,) * (x.ndim - 3) + (half,))
    cos, sin = jnp.cos(ang), jnp.sin(ang)
    x32 = x.astype(jnp.float32)
    x1, x2 = x32[..., :half], x32[..., half:]
    return jnp.concatenate([x1 * cos - x2 * sin, x2 * cos + x1 * sin], axis=-1).astype(x.dtype)


def diff_attention(q, k, v, positions, qn_g, kn_g, lam_vecs, subln_g, lambda_init):
    b, s, h, _, d = q.shape
    q = rope(rmsnorm(q, qn_g), positions) * (d ** -0.5)
    k = rope(rmsnorm(k, kn_g), positions)
    lv = lam_vecs.astype(jnp.float32)
    lam = jnp.exp(jnp.sum(lv[0] * lv[1])) - jnp.exp(jnp.sum(lv[2] * lv[3])) + lambda_init
    nblk = s // Q_BLOCK
    qb = q.reshape(b, nblk, Q_BLOCK, h, 2, d).transpose(1, 0, 2, 3, 4, 5)
    key_idx = jnp.arange(s)

    def block(args):
        q_blk, i = args
        scores = jnp.einsum('bqhmd,bkhmd->bhmqk', q_blk, k).astype(jnp.float32)
        q_idx = i * Q_BLOCK + jnp.arange(Q_BLOCK)
        mask = key_idx[None, :] <= q_idx[:, None]
        p = jax.nn.softmax(jnp.where(mask, scores, -jnp.inf), axis=-1)
        w = p[:, :, 0] - lam * p[:, :, 1]
        return jnp.einsum('bhqk,bkhe->bqhe', w.astype(v.dtype), v)

    o = lax.map(block, (qb, jnp.arange(nblk)))
    o = o.transpose(1, 0, 2, 3, 4).reshape(b, s, h, ATTN_V_DIM)
    o = rmsnorm(o, subln_g) * (1.0 - lambda_init)
    return o.reshape(b, s, h * ATTN_V_DIM)


def causal_depthwise_conv(u, w, bias):
    ch = u.shape[-1]
    out = lax.conv_general_dilated(u, w[:, None, :].astype(u.dtype), window_strides=(1,),
                                   padding=[(SSD_CONV - 1, 0)],
                                   dimension_numbers=('NWC', 'WIO', 'NWC'),
                                   feature_group_count=ch)
    return out + bias


def segsum_exp(a_cum):
    l = a_cum.shape[-1]
    diff = a_cum[..., :, None] - a_cum[..., None, :]
    mask = jnp.tril(jnp.ones((l, l), dtype=bool))
    return jnp.exp(jnp.where(mask, diff, -jnp.inf))


def ssd_chunked(x, a, bm, cm):
    b, s, g, j, p = x.shape
    n = bm.shape[-1]
    c, l = s // SSD_CHUNK, SSD_CHUNK
    x = x.reshape(b, c, l, g, j, p)
    bm = bm.reshape(b, c, l, g, n)
    cm = cm.reshape(b, c, l, g, n)
    a = a.reshape(b, c, l, g, j).transpose(0, 3, 4, 1, 2).astype(jnp.float32)
    a_cum = jnp.cumsum(a, axis=-1)
    lmat = segsum_exp(a_cum)
    cb = jnp.einsum('bclgn,bcsgn->bgcls', cm, bm)
    y_diag = jnp.einsum('bgcls,bgjcls,bcsgjp->bclgjp', cb, lmat, x)
    decay_states = jnp.exp(a_cum[..., -1:] - a_cum)
    states = jnp.einsum('bclgn,bgjcl,bclgjp->bcgjpn', bm, decay_states, x)
    chunk_decay = jnp.exp(a_cum[..., -1])

    def step(hstate, inp):
        st, dec = inp
        return hstate * dec[..., None, None] + st, hstate

    h0 = jnp.zeros((b, g, j, p, n), jnp.float32)
    _, prev = lax.scan(step, h0, (states.transpose(1, 0, 2, 3, 4, 5).astype(jnp.float32),
                                  chunk_decay.transpose(3, 0, 1, 2)))
    y_off = jnp.einsum('bclgn,cbgjpn,bgjcl->bclgjp', cm, prev, jnp.exp(a_cum))
    return (y_diag + y_off).reshape(b, s, g, j, p)


def ssd_mixer(z, xbc, dt, conv_w, conv_b, dt_bias, a_log, d_skip, norm_g):
    b, s, _ = z.shape
    xbc = jax.nn.silu(causal_depthwise_conv(xbc, conv_w, conv_b))
    gn = SSD_GROUPS * SSD_D_STATE
    xs = xbc[..., :SSD_D_INNER].reshape(b, s, SSD_GROUPS, SSD_HEADS_PER_GROUP, SSD_HEAD_DIM)
    bm = xbc[..., SSD_D_INNER:SSD_D_INNER + gn].reshape(b, s, SSD_GROUPS, SSD_D_STATE)
    cm = xbc[..., SSD_D_INNER + gn:].reshape(b, s, SSD_GROUPS, SSD_D_STATE)
    dtp = jax.nn.softplus(dt.astype(jnp.float32) + dt_bias.astype(jnp.float32))
    dtp = dtp.reshape(b, s, SSD_GROUPS, SSD_HEADS_PER_GROUP)
    a_neg = -jnp.exp(a_log.astype(jnp.float32)).reshape(SSD_GROUPS, SSD_HEADS_PER_GROUP)
    y = ssd_chunked(xs * dtp[..., None], dtp * a_neg, bm, cm)
    y = y + xs * d_skip.reshape(SSD_GROUPS, SSD_HEADS_PER_GROUP)[..., None]
    y = y.reshape(b, s, SSD_D_INNER).astype(z.dtype) * jax.nn.silu(z)
    y = rmsnorm(y.reshape(b, s, SSD_GROUPS, SSD_D_INNER // SSD_GROUPS),
                norm_g.reshape(SSD_GROUPS, SSD_D_INNER // SSD_GROUPS))
    return y.reshape(b, s, SSD_D_INNER)


def moe_ffn(h, w_router, router_bias, w_eg, w_eu, w_ed, w_sg, w_su, w_sd):
    b, s, d = h.shape
    t = h.reshape(b * s, d)
    ntok = b * s
    scores = jax.nn.sigmoid((t @ w_router).astype(jnp.float32))
    choice = scores + router_bias.astype(jnp.float32)
    per_group = N_EXPERTS // N_EXPERT_GROUPS
    grp_score = lax.top_k(choice.reshape(ntok, N_EXPERT_GROUPS, per_group), 2)[0].sum(-1)
    _, top_grp = lax.top_k(grp_score, TOPK_GROUPS)
    grp_mask = jax.nn.one_hot(top_grp, N_EXPERT_GROUPS, dtype=jnp.float32).sum(-2)
    expert_mask = jnp.repeat(grp_mask, per_group, axis=-1) > 0
    _, idx = lax.top_k(jnp.where(expert_mask, choice, -jnp.inf), TOP_K)
    w = jnp.take_along_axis(scores, idx, axis=-1)
    w = w / jnp.sum(w, axis=-1, keepdims=True) * ROUTED_SCALE
    gates = jnp.einsum('tk,tke->te', w, jax.nn.one_hot(idx, N_EXPERTS, dtype=jnp.float32))
    nb = ntok // MOE_TOKEN_BLOCK

    def block(args):
        tb, gb = args
        g = jnp.einsum('td,edf->tef', tb, w_eg)
        u = jnp.einsum('td,edf->tef', tb, w_eu)
        act = jax.nn.silu(g) * u * gb[:, :, None].astype(tb.dtype)
        return jnp.einsum('tef,efd->td', act, w_ed)

    routed = lax.map(block, (t.reshape(nb, MOE_TOKEN_BLOCK, d),
                             gates.reshape(nb, MOE_TOKEN_BLOCK, N_EXPERTS))).reshape(ntok, d)
    shared = (jax.nn.silu(t @ w_sg) * (t @ w_su)) @ w_sd
    return (routed + shared).reshape(b, s, d)


def setup_inputs(seed: int = 0) -> dict:
    key = jax.random.key(seed)
    ks = jax.random.split(key, 32)
    f32 = jnp.float32
    L, D = DEPTH, D_MODEL

    def nrm(k, shape, scale):
        return jax.random.normal(k, shape, f32) * scale

    x = jax.random.normal(ks[0], (BATCH, SEQ, D), f32)
    c = jax.random.normal(ks[1], (BATCH, D), f32)
    offs = jax.random.randint(ks[2], (BATCH, 1), 0, 1024, dtype=jnp.int32)
    positions = offs + jnp.arange(SEQ, dtype=jnp.int32)[None, :]
    dt0 = jnp.exp(jax.random.uniform(ks[12], (L, SSD_HEADS), f32, math.log(1e-3), math.log(1e-1)))
    return {
        "x": x,
        "c": c,
        "positions": positions,
        "w_ada": nrm(ks[3], (L, D, 6 * D), 0.5 * D ** -0.5),
        "b_ada": nrm(ks[4], (L, 6 * D), 0.02),
        "norm1_g": 1.0 + nrm(ks[5], (L, D), 0.1),
        "w_in": nrm(ks[6], (L, D, IN_WIDTH), D ** -0.5),
        "q_norm_g": 1.0 + nrm(ks[7], (L, ATTN_HEAD_DIM), 0.1),
        "k_norm_g": 1.0 + nrm(ks[8], (L, ATTN_HEAD_DIM), 0.1),
        "lambda_qk": nrm(ks[9], (L, 4, ATTN_HEAD_DIM), 0.1),
        "subln_g": 1.0 + nrm(ks[10], (L, ATTN_V_DIM), 0.1),
        "conv_w": nrm(ks[11], (L, SSD_CONV, SSD_CONV_DIM), 0.5),
        "conv_b": nrm(ks[13], (L, SSD_CONV_DIM), 0.02),
        "dt_bias": dt0 + jnp.log(-jnp.expm1(-dt0)),
        "a_log": jnp.log(jax.random.uniform(ks[14], (L, SSD_HEADS), f32, 1.0, 16.0)),
        "d_skip": 1.0 + nrm(ks[15], (L, SSD_HEADS), 0.1),
        "ssd_norm_g": 1.0 + nrm(ks[16], (L, SSD_D_INNER), 0.1),
        "w_branch_a": nrm(ks[17], (L, ATTN_V_WIDTH, D), ATTN_V_WIDTH ** -0.5),
        "w_branch_b": nrm(ks[18], (L, SSD_D_INNER, D), SSD_D_INNER ** -0.5),
        "w_out": nrm(ks[19], (L, D, D), D ** -0.5),
        "norm2_g": 1.0 + nrm(ks[20], (L, D), 0.1),
        "w_router": nrm(ks[21], (L, D, N_EXPERTS), D ** -0.5),
        "router_bias": nrm(ks[22], (L, N_EXPERTS), 0.01),
        "w_exp_gate": nrm(ks[23], (L, N_EXPERTS, D, EXPERT_DIM), D ** -0.5),
        "w_exp_up": nrm(ks[24], (L, N_EXPERTS, D, EXPERT_DIM), D ** -0.5),
        "w_exp_down": nrm(ks[25], (L, N_EXPERTS, EXPERT_DIM, D), EXPERT_DIM ** -0.5),
        "w_sh_gate": nrm(ks[26], (L, D, SHARED_DIM), D ** -0.5),
        "w_sh_up": nrm(ks[27], (L, D, SHARED_DIM), D ** -0.5),
        "w_sh_down": nrm(ks[28], (L, SHARED_DIM, D), SHARED_DIM ** -0.5),
    }


def reference(x, c, positions, w_ada, b_ada, norm1_g, w_in, q_norm_g, k_norm_g, lambda_qk, subln_g,
              conv_w, conv_b, dt_bias, a_log, d_skip, ssd_norm_g, w_branch_a, w_branch_b, w_out,
              norm2_g, w_router, router_bias, w_exp_gate, w_exp_up, w_exp_down,
              w_sh_gate, w_sh_up, w_sh_down):
    b, s, _ = x.shape
    offsets = [int(o) for o in np.cumsum(IN_SIZES)[:-1]]
    for layer in range(DEPTH):
        lambda_init = 0.8 - 0.6 * math.exp(-0.3 * layer)
        mod = jax.nn.silu(c) @ w_ada[layer] + b_ada[layer]
        sh1, sc1, g1, sh2, sc2, g2 = jnp.split(mod[:, None, :], 6, axis=-1)
        h = rmsnorm(x, norm1_g[layer]) * (1.0 + sc1) + sh1
        proj = h @ w_in[layer]
        q, k, v, ga, gb, z, xbc, dt = jnp.split(proj, offsets, axis=-1)
        q = q.reshape(b, s, ATTN_HEADS, 2, ATTN_HEAD_DIM)
        k = k.reshape(b, s, ATTN_HEADS, 2, ATTN_HEAD_DIM)
        v = v.reshape(b, s, ATTN_HEADS, ATTN_V_DIM)
        ya = diff_attention(q, k, v, positions, q_norm_g[layer], k_norm_g[layer],
                            lambda_qk[layer], subln_g[layer], lambda_init)
        yb = ssd_mixer(z, xbc, dt, conv_w[layer], conv_b[layer], dt_bias[layer],
                       a_log[layer], d_skip[layer], ssd_norm_g[layer])
        merged = (jax.nn.sigmoid(ga) * (ya @ w_branch_a[layer])
                  + jax.nn.sigmoid(gb) * (yb @ w_branch_b[layer]))
        x = x + g1 * (merged @ w_out[layer])
        h2 = rmsnorm(x, norm2_g[layer]) * (1.0 + sc2) + sh2
        x = x + g2 * moe_ffn(h2, w_router[layer], router_bias[layer], w_exp_gate[layer],
                             w_exp_up[layer], w_exp_down[layer], w_sh_gate[layer],
                             w_sh_up[layer], w_sh_down[layer])
    return x
```

```cpp
#include <hip/hip_runtime.h>
#include <cstdint>
#include <cstdio>

#define LAS __attribute__((address_space(3)))
#define GAS __attribute__((address_space(1)))
typedef unsigned short bf16;
typedef unsigned v4u __attribute__((ext_vector_type(4)));
typedef unsigned v2u __attribute__((ext_vector_type(2)));
typedef float f32x4 __attribute__((ext_vector_type(4)));
typedef float f32x2 __attribute__((ext_vector_type(2)));
typedef float f32x16 __attribute__((ext_vector_type(16)));
typedef short bf16x8 __attribute__((ext_vector_type(8)));
typedef short s16x4 __attribute__((ext_vector_type(4)));

constexpr int BATCH = 2, SEQ = 8192, DM = 1024, T = BATCH * SEQ;
constexpr int INW = 10272;
constexpr int C_Q = 0, C_K = 1024, C_V = 2048, C_GA = 3072, C_GB = 4096, C_Z = 5120, C_XBC = 7168, C_DT = 10240;
constexpr int NHEAD = 8, HD = 64, VD = 128;
constexpr int SSD_H = 32, SSD_P = 64, SSD_G = 4, SSD_N = 128, SSD_L = 128, SSD_NC = SEQ / SSD_L, CONV_DIM = 3072, DIN = 2048;
constexpr int NEXP = 64, TOPK = 8, EDIM = 256;
constexpr float EPS = 1e-6f;
constexpr float LAMBDA_INIT = 0.2f;
constexpr float ROUTED_SCALE = 2.5f;
constexpr int NTHR = 512, NWAVE = 8;

constexpr size_t MiB = 1u << 20;
constexpr size_t WS_CTL = 0;
constexpr size_t CTL_ZERO_BYTES = 65536;
constexpr size_t WS_MODV = 1 * MiB;
constexpr size_t WS_DTP = 2 * MiB;
constexpr size_t WS_ROPE = 4 * MiB;
constexpr size_t WS_CD = 8 * MiB;
constexpr size_t WS_PAIRW = 9 * MiB;
constexpr size_t WS_PAIRE = 9 * MiB + 512 * 1024;
constexpr size_t WS_LISTS = 10 * MiB;
constexpr size_t WS_WTA = 14 * MiB, WS_WTB = 16 * MiB, WS_WTOUT = 20 * MiB, WS_WTDT = 22 * MiB;
constexpr size_t WS_H = 24 * MiB;
constexpr size_t WS_A = 56 * MiB;
constexpr size_t WS_B = 120 * MiB;
constexpr size_t WS_C = 216 * MiB;
constexpr size_t WS_D = 280 * MiB;
constexpr size_t WS_WTIN = 312 * MiB;
constexpr size_t WS_END = 332 * MiB;
constexpr size_t WS_Q = WS_B, WS_K = WS_B + 32 * MiB, WS_V = WS_B + 64 * MiB;
constexpr size_t WS_GA = WS_C, WS_GB = WS_C + 32 * MiB;
constexpr size_t WS_MG = 120 * MiB;
constexpr size_t WS_MIX = WS_H;
constexpr size_t WS_ACT = 56 * MiB;
constexpr size_t WS_WTD = 128 * MiB;
constexpr size_t WS_WTGU = 161 * MiB;
constexpr size_t WS_H2 = 226 * MiB;
constexpr size_t WS_Y = 161 * MiB;

__device__ __forceinline__ unsigned f2bf(float f) { unsigned u = __builtin_bit_cast(unsigned, f); return (u + 0x7fffu + ((u >> 16) & 1u)) >> 16; }
__device__ __forceinline__ float bf2f(unsigned h) { return __builtin_bit_cast(float, (h & 0xffffu) << 16); }
__device__ __forceinline__ unsigned pk2(float lo, float hi) { return f2bf(lo) | (f2bf(hi) << 16); }
__device__ __forceinline__ float sigmoidf_(float x) { return 1.f / (1.f + __expf(-x)); }
__device__ __forceinline__ float siluf_(float x) { return x / (1.f + __expf(-x)); }
__device__ __forceinline__ float softplusf_(float x) { return x > 20.f ? x : log1pf(__expf(x)); }
__device__ __forceinline__ float wave_sum(float v) {
#pragma unroll
    for (int o = 1; o < 64; o <<= 1) v += __shfl_xor(v, o);
    return v;
}
__device__ __forceinline__ float block_sum(float v, LAS float* red) {
    v = wave_sum(v);
    __syncthreads();
    if ((threadIdx.x & 63) == 0) red[threadIdx.x >> 6] = v;
    __syncthreads();
    float s = 0.f;
#pragma unroll
    for (int i = 0; i < NWAVE; ++i) s += red[i];
    return s;
}

struct P {
    const float* x; const float* c; const int* positions; const float* w_ada; const float* b_ada; const float* norm1_g; const float* w_in;
    const float* q_norm_g; const float* k_norm_g; const float* lambda_qk; const float* subln_g; const float* conv_w; const float* conv_b;
    const float* dt_bias; const float* a_log; const float* d_skip; const float* ssd_norm_g; const float* w_branch_a; const float* w_branch_b;
    const float* w_out; const float* norm2_g; const float* w_router; const float* router_bias; const float* w_exp_gate; const float* w_exp_up;
    const float* w_exp_down; const float* w_sh_gate; const float* w_sh_up; const float* w_sh_down;
    float* out; unsigned char* ws; int ph_lo, ph_hi;
};
#define XB_TMO      128
#define XB_XCNT(j)  (256  + 64 * (j))
#define XB_XSUB(j)  (1280 + 64 * (j))
#define XB_XGEN(j)  (2304 + 64 * (j))
#define XB_TOP      3328
#define XB_TOPGEN   3392
#define XCD_BAR_WORDS 3456
#define XB_SPIN_CAP (1u << 18)

__device__ __forceinline__ unsigned xb_ld(unsigned* p)              { return __hip_atomic_load(p, __ATOMIC_RELAXED, __HIP_MEMORY_SCOPE_AGENT); }
__device__ __forceinline__ unsigned xb_add(unsigned* p, unsigned v) { return __hip_atomic_fetch_add(p, v, __ATOMIC_RELAXED, __HIP_MEMORY_SCOPE_AGENT); }
__device__ __forceinline__ unsigned xb_xcc_id() { return (unsigned)__builtin_amdgcn_s_getreg((3 << 11) | 20) & 0xFu; }
#define XB_SPIN(cond, bar) do { unsigned _sp = 0; while (cond) { __builtin_amdgcn_s_sleep(1); \
    if ((++_sp & 255u) == 0u) { if (xb_ld(&(bar)[XB_TMO])) break; if (_sp > XB_SPIN_CAP) { atomicAdd(&(bar)[XB_TMO], 1u); break; } } } } while (0)

struct XcdBarrier {
    unsigned* bar; unsigned x;
    volatile LAS unsigned* st;
};

__device__ __forceinline__ XcdBarrier xcd_barrier_post(unsigned* bar, volatile LAS unsigned* st) {
    XcdBarrier b; b.bar = bar; b.x = xb_xcc_id(); b.st = st;
    if (threadIdx.x == 0) (void)xb_add(&bar[XB_XCNT(b.x)], 1u);
    return b;
}
__device__ __forceinline__ void xcd_barrier_complete(unsigned* bar, unsigned x, unsigned& nloc, unsigned& nx) {
    const unsigned G = gridDim.x * gridDim.y * gridDim.z;
    unsigned sum, cnt, mine, sp = 0u;
    for (;;) {
        sum = 0u; cnt = 0u; mine = 0u;
#pragma unroll
        for (unsigned j = 0; j < 16; ++j) { const unsigned c = xb_ld(&bar[XB_XCNT(j)]); sum += c; cnt += (c > 0u) ? 1u : 0u; mine = (j == x) ? c : mine; }
        if (sum == G) break;
        __builtin_amdgcn_s_sleep(1);
        if ((++sp & 255u) == 0u) { if (xb_ld(&bar[XB_TMO])) break; if (sp > XB_SPIN_CAP) { atomicAdd(&bar[XB_TMO], 1u); break; } }
    }
    nloc = mine > 0u ? mine : 1u; nx = cnt > 0u ? cnt : 1u;
}

__device__ __forceinline__ void xcd_barrier(const XcdBarrier& b) {
    asm volatile("s_waitcnt vmcnt(0)" ::: "memory");
    __syncthreads();
    if (threadIdx.x == 0) {
        unsigned* bar = b.bar;
        __builtin_amdgcn_s_waitcnt(0);
        unsigned nloc = b.st[0], nx = b.st[1];
        if (nloc == 0u) { xcd_barrier_complete(bar, b.x, nloc, nx); b.st[0] = nloc; b.st[1] = nx; }
        const unsigned old = xb_add(&bar[XB_XSUB(b.x)], 1u);
        const unsigned gen = old / nloc;
        if (old + 1u == (gen + 1u) * nloc) {
            __builtin_amdgcn_fence(__ATOMIC_RELEASE, "agent");
            asm volatile("s_waitcnt vmcnt(0)" ::: "memory");
            const unsigned og = xb_add(&bar[XB_TOP], 1u);
            const unsigned tg = og / nx;
            if (og + 1u == (tg + 1u) * nx) xb_add(&bar[XB_TOPGEN], 1u);
            else XB_SPIN(xb_ld(&bar[XB_TOPGEN]) == tg, bar);
            __builtin_amdgcn_fence(__ATOMIC_ACQUIRE, "agent");
            xb_add(&bar[XB_XGEN(b.x)], 1u);
            asm volatile("s_waitcnt vmcnt(0)" ::: "memory");
        } else {
            XB_SPIN(xb_ld(&bar[XB_XGEN(b.x)]) == gen, bar);
            __builtin_amdgcn_fence(__ATOMIC_ACQUIRE, "agent");
            asm volatile("s_waitcnt vmcnt(0)" ::: "memory");
        }
    }
    __syncthreads();
}

namespace nv {

__device__ __forceinline__ void n0_mod_rope(const P& p) {
    float* modv = (float*)(p.ws + WS_MODV);
    float* rope = (float*)(p.ws + WS_ROPE);
    const int gtid = blockIdx.x * NTHR + threadIdx.x, gn = gridDim.x * NTHR;
    for (int i = gtid; i < BATCH * 6 * DM; i += gn) {
        const int b = i / (6 * DM), j = i % (6 * DM);
        float s = p.b_ada[j];
        for (int k = 0; k < DM; ++k) s += siluf_(p.c[b * DM + k]) * p.w_ada[(size_t)k * 6 * DM + j];
        modv[i] = s;
    }
    for (int i = gtid; i < T * 32; i += gn) {
        const int t = i >> 5, f = i & 31;
        const float inv = powf(10000.0f, -(float)f / 32.0f);
        const float ang = (float)p.positions[t] * inv;
        float sn, cs; sincosf(ang, &sn, &cs);
        rope[2 * i] = cs; rope[2 * i + 1] = sn;
    }
}

__device__ __forceinline__ void n1_h(const P& p, const float* xin, const bf16* mixin, const float* g, int sc_off, int sh_off, bf16* H) {
    const float* modv = (const float*)(p.ws + WS_MODV);
    const int lane = threadIdx.x & 63, gw = blockIdx.x * NWAVE + (threadIdx.x >> 6), ngw = gridDim.x * NWAVE;
    for (int t = gw; t < T; t += ngw) {
        const int b = t / SEQ;
        float v[16]; float ss = 0.f;
#pragma unroll
        for (int j = 0; j < 16; ++j) { const int k = lane + 64 * j; float a = xin[(size_t)t * DM + k]; if (mixin) a += bf2f(mixin[(size_t)t * DM + k]); v[j] = a; ss += a * a; }
        ss = wave_sum(ss);
        const float r = rsqrtf(ss * (1.f / DM) + EPS);
#pragma unroll
        for (int j = 0; j < 16; ++j) { const int k = lane + 64 * j;
            const float o = v[j] * r * g[k] * (1.f + modv[b * 6 * DM + sc_off + k]) + modv[b * 6 * DM + sh_off + k];
            H[(size_t)t * DM + k] = (bf16)f2bf(o); }
    }
}

template <class LA, class LB, class EP>
__device__ __forceinline__ void ngemm(int M, int N, int K, LA la, LB lb, EP ep, LAS float* sm) {
    LAS float* As = sm;
    LAS float* Bs = sm + 16 * 132;
    const int tid = threadIdx.x, ty = tid >> 4, tx = tid & 15;
    const int ntm = M / 128, ntn = (N + 63) / 64;
    for (int tile = blockIdx.x; tile < ntm * ntn; tile += gridDim.x) {
        const int tm = tile / ntn, tn = tile % ntn;
        float acc[4][4];
#pragma unroll
        for (int i = 0; i < 4; ++i)
#pragma unroll
            for (int j = 0; j < 4; ++j) acc[i][j] = 0.f;
        for (int k0 = 0; k0 < K; k0 += 16) {
#pragma unroll
            for (int i = 0; i < 4; ++i) { const int idx = tid + i * 512, m = idx >> 4, k = idx & 15; As[k * 132 + m] = la(tm * 128 + m, k0 + k); }
#pragma unroll
            for (int i = 0; i < 2; ++i) { const int idx = tid + i * 512, k = idx >> 6, n = idx & 63; Bs[k * 64 + n] = (tn * 64 + n < N) ? lb(k0 + k, tn * 64 + n) : 0.f; }
            __syncthreads();
#pragma unroll
            for (int k = 0; k < 16; ++k) {
                const f32x4 a = *(const LAS f32x4*)(As + k * 132 + ty * 4);
                const f32x4 b = *(const LAS f32x4*)(Bs + k * 64 + tx * 4);
#pragma unroll
                for (int i = 0; i < 4; ++i)
#pragma unroll
                    for (int j = 0; j < 4; ++j) acc[i][j] += a[i] * b[j];
            }
            __syncthreads();
        }
#pragma unroll
        for (int i = 0; i < 4; ++i)
#pragma unroll
            for (int j = 0; j < 4; ++j) { const int m = tm * 128 + ty * 4 + i, n = tn * 64 + tx * 4 + j; if (n < N) ep(m, n, acc[i][j]); }
    }
}

__device__ __forceinline__ void n2_proj(const P& p, int c0, int c1, LAS float* sm) {
    const bf16* H = (const bf16*)(p.ws + WS_H);
    const float* w_in = p.w_in;
    bf16* Q = (bf16*)(p.ws + WS_Q); bf16* Kb = (bf16*)(p.ws + WS_K); bf16* V = (bf16*)(p.ws + WS_V);
    bf16* GA = (bf16*)(p.ws + WS_GA); bf16* GB = (bf16*)(p.ws + WS_GB); bf16* ZS = (bf16*)(p.ws + WS_A); bf16* XBC = (bf16*)(p.ws + WS_B);
    float* DTP = (float*)(p.ws + WS_DTP); const float* dt_bias = p.dt_bias;
    ngemm(T, c1 - c0, DM,
        [=](int m, int k) { return bf2f(H[(size_t)m * DM + k]); },
        [=](int k, int n) { return w_in[(size_t)k * INW + c0 + n]; },
        [=](int m, int n, float v) {
            const int c = c0 + n;
            if (c < C_K) Q[(size_t)m * 1024 + c] = (bf16)f2bf(v);
            else if (c < C_V) Kb[(size_t)m * 1024 + (c - C_K)] = (bf16)f2bf(v);
            else if (c < C_GA) V[(size_t)m * 1024 + (c - C_V)] = (bf16)f2bf(v);
            else if (c < C_GB) GA[(size_t)m * 1024 + (c - C_GA)] = (bf16)f2bf(sigmoidf_(v));
            else if (c < C_Z) GB[(size_t)m * 1024 + (c - C_GB)] = (bf16)f2bf(sigmoidf_(v));
            else if (c < C_XBC) ZS[(size_t)m * 2048 + (c - C_Z)] = (bf16)f2bf(siluf_(v));
            else if (c < C_DT) XBC[(size_t)m * 3072 + (c - C_XBC)] = (bf16)f2bf(v);
            else DTP[(size_t)m * 32 + (c - C_DT)] = softplusf_(v + dt_bias[c - C_DT]);
        }, sm);
}

__device__ __forceinline__ void n3_conv(const P& p, bf16* XC) {
    const bf16* XBC = (const bf16*)(p.ws + WS_B);
    const int gtid = blockIdx.x * NTHR + threadIdx.x, gn = gridDim.x * NTHR;
    for (size_t i = gtid; i < (size_t)T * CONV_DIM; i += gn) {
        const int t = (int)(i / CONV_DIM), c = (int)(i % CONV_DIM), s = t % SEQ;
        float a = p.conv_b[c];
#pragma unroll
        for (int j = 0; j < 4; ++j) { const int ss = s - 3 + j; if (ss >= 0) a += p.conv_w[j * CONV_DIM + c] * bf2f(XBC[(size_t)(t - 3 + j) * CONV_DIM + c]); }
        XC[i] = (bf16)f2bf(siluf_(a));
    }
}

__device__ __forceinline__ void n4_ssd_seq(const P& p, const bf16* XC, bf16* YR, LAS float* sm) {
    const float* DTP = (const float*)(p.ws + WS_DTP);
    const int tid = threadIdx.x, pp = tid >> 3, nq = tid & 7;
    constexpr int ST = 32;
    LAS float* sB = sm;
    LAS float* sC = sm + ST * 128;
    LAS float* sX = sm + 2 * ST * 128;
    LAS float* sD = sm + 2 * ST * 128 + ST * 64;
    for (int u = blockIdx.x; u < BATCH * SSD_H; u += gridDim.x) {
        const int b = u / SSD_H, hd = u % SSD_H, g = hd / 8;
        const float A = -__expf(p.a_log[hd]), Dk = p.d_skip[hd];
        float st[16];
#pragma unroll
        for (int i = 0; i < 16; ++i) st[i] = 0.f;
        for (int s0 = 0; s0 < SEQ; s0 += ST) {
            __syncthreads();
            for (int i = tid; i < ST * 128; i += NTHR) { const int ts = i >> 7, n = i & 127; const size_t row = (size_t)(b * SEQ + s0 + ts) * CONV_DIM;
                sB[i] = bf2f(XC[row + DIN + g * 128 + n]); sC[i] = bf2f(XC[row + DIN + 512 + g * 128 + n]); }
            for (int i = tid; i < ST * 64; i += NTHR) { const int ts = i >> 6, q = i & 63; sX[i] = bf2f(XC[(size_t)(b * SEQ + s0 + ts) * CONV_DIM + hd * 64 + q]); }
            if (tid < ST) sD[tid] = DTP[(size_t)(b * SEQ + s0 + tid) * 32 + hd];
            __syncthreads();
            for (int ts = 0; ts < ST; ++ts) {
                const float dt = sD[ts], dec = __expf(dt * A), xv = sX[ts * 64 + pp], xd = xv * dt;
                float y = 0.f;
#pragma unroll
                for (int i = 0; i < 16; ++i) { const int n = nq * 16 + i; st[i] = st[i] * dec + xd * sB[ts * 128 + n]; y += st[i] * sC[ts * 128 + n]; }
                y += __shfl_xor(y, 1); y += __shfl_xor(y, 2); y += __shfl_xor(y, 4);
                if (nq == 0) YR[(size_t)(b * SEQ + s0 + ts) * DIN + hd * 64 + pp] = (bf16)f2bf(y + Dk * xv);
            }
        }
    }
}

__device__ __forceinline__ void n5_gate_norm(const P& p, const bf16* YR, bf16* ZSYB) {
    const int lane = threadIdx.x & 63, gw = blockIdx.x * NWAVE + (threadIdx.x >> 6), ngw = gridDim.x * NWAVE;
    for (int u = gw; u < T * SSD_G; u += ngw) {
        const int t = u >> 2, g = u & 3;
        float v[8]; float ss = 0.f;
#pragma unroll
        for (int j = 0; j < 8; ++j) { const size_t idx = (size_t)t * DIN + g * 512 + lane + 64 * j; const float a = bf2f(YR[idx]) * bf2f(ZSYB[idx]); v[j] = a; ss += a * a; }
        ss = wave_sum(ss);
        const float r = rsqrtf(ss * (1.f / 512.f) + EPS);
#pragma unroll
        for (int j = 0; j < 8; ++j) { const int cidx = g * 512 + lane + 64 * j; ZSYB[(size_t)t * DIN + cidx] = (bf16)f2bf(v[j] * r * p.ssd_norm_g[cidx]); }
    }
}

__device__ __forceinline__ void n6b_qknorm(const P& p, float qscale) {
    bf16* Q = (bf16*)(p.ws + WS_Q); bf16* Kb = (bf16*)(p.ws + WS_K);
    const float* rope = (const float*)(p.ws + WS_ROPE);
    const int lane = threadIdx.x & 63, gw = blockIdx.x * NWAVE + (threadIdx.x >> 6), ngw = gridDim.x * NWAVE;
    for (int u = gw; u < 2 * T * 8; u += ngw) {
        const int which = u / (T * 8), r = u % (T * 8), t = r >> 3, hp = r & 7;
        bf16* base = (which ? Kb : Q) + (size_t)t * 1024 + (hp * 2 + (lane >> 5)) * 64;
        const float* g = which ? p.k_norm_g : p.q_norm_g;
        const int i = lane & 31;
        const float x1 = bf2f(base[i]), x2 = bf2f(base[i + 32]);
        float ss = x1 * x1 + x2 * x2;
        ss += __shfl_xor(ss, 1); ss += __shfl_xor(ss, 2); ss += __shfl_xor(ss, 4); ss += __shfl_xor(ss, 8); ss += __shfl_xor(ss, 16);
        const float rr = rsqrtf(ss * (1.f / 64.f) + EPS);
        const float a1 = x1 * rr * g[i], a2 = x2 * rr * g[i + 32];
        const float cs = rope[((size_t)t * 32 + i) * 2], sn = rope[((size_t)t * 32 + i) * 2 + 1];
        const float sc = which ? 1.f : qscale;
        base[i] = (bf16)f2bf((a1 * cs - a2 * sn) * sc); base[i + 32] = (bf16)f2bf((a2 * cs + a1 * sn) * sc);
    }
}

__device__ __forceinline__ void n7_attn(const P& p, bf16* YA, LAS float* sm) {
    const bf16* Q = (const bf16*)(p.ws + WS_Q); const bf16* Kb = (const bf16*)(p.ws + WS_K); const bf16* V = (const bf16*)(p.ws + WS_V);
    LAS float* sQ = sm;
    LAS float* sK = sm + 64 * 65;
    LAS float* sV = sm + 2 * 64 * 65;
    LAS float* sP = sm + 2 * 64 * 65 + 64 * 128;
    const int tid = threadIdx.x, qi = tid >> 3, part = tid & 7;
    float lam;
    { float a = 0.f, bq = 0.f; for (int i = 0; i < 64; ++i) { a += p.lambda_qk[i] * p.lambda_qk[64 + i]; bq += p.lambda_qk[128 + i] * p.lambda_qk[192 + i]; } lam = __expf(a) - __expf(bq) + LAMBDA_INIT; }
    for (int u = blockIdx.x; u < BATCH * NHEAD * (SEQ / 64); u += gridDim.x) {
        const int b = u / (NHEAD * (SEQ / 64)), h = (u / (SEQ / 64)) % NHEAD, qb = u % (SEQ / 64);
        float oc[16];
#pragma unroll
        for (int j = 0; j < 16; ++j) oc[j] = 0.f;
        for (int m = 0; m < 2; ++m) {
            __syncthreads();
            for (int i = tid; i < 64 * 64; i += NTHR) { const int r = i >> 6, d = i & 63; sQ[r * 65 + d] = bf2f(Q[(size_t)(b * SEQ + qb * 64 + r) * 1024 + (h * 2 + m) * 64 + d]); }
            float o[16]; float mx = -INFINITY, l = 0.f;
#pragma unroll
            for (int j = 0; j < 16; ++j) o[j] = 0.f;
            for (int kb = 0; kb <= qb; ++kb) {
                __syncthreads();
                for (int i = tid; i < 64 * 64; i += NTHR) { const int r = i >> 6, d = i & 63; sK[r * 65 + d] = bf2f(Kb[(size_t)(b * SEQ + kb * 64 + r) * 1024 + (h * 2 + m) * 64 + d]); }
                for (int i = tid; i < 64 * 128; i += NTHR) { const int r = i >> 7, e = i & 127; sV[r * 128 + e] = bf2f(V[(size_t)(b * SEQ + kb * 64 + r) * 1024 + h * 128 + e]); }
                __syncthreads();
                float s[8]; float tmx = -INFINITY;
#pragma unroll
                for (int j = 0; j < 8; ++j) { const int kk = part * 8 + j; float a = 0.f;
                    for (int d = 0; d < 64; ++d) a += sQ[qi * 65 + d] * sK[kk * 65 + d];
                    if (kb == qb && kk > qi) a = -INFINITY;
                    s[j] = a; tmx = fmaxf(tmx, a); }
                tmx = fmaxf(tmx, __shfl_xor(tmx, 1)); tmx = fmaxf(tmx, __shfl_xor(tmx, 2)); tmx = fmaxf(tmx, __shfl_xor(tmx, 4));
                const float mn = fmaxf(mx, tmx), f = exp2f(mx - mn);
                float ls = 0.f;
#pragma unroll
                for (int j = 0; j < 8; ++j) { const float e = exp2f(s[j] - mn); sP[qi * 65 + part * 8 + j] = e; ls += e; }
                ls += __shfl_xor(ls, 1); ls += __shfl_xor(ls, 2); ls += __shfl_xor(ls, 4);
                l = l * f + ls; mx = mn;
#pragma unroll
                for (int j = 0; j < 16; ++j) o[j] *= f;
                __syncthreads();
                for (int kk = 0; kk < 64; ++kk) { const float pv = sP[qi * 65 + kk];
#pragma unroll
                    for (int j = 0; j < 16; ++j) o[j] += pv * sV[kk * 128 + part * 16 + j]; }
            }
            const float il = 1.f / l;
#pragma unroll
            for (int j = 0; j < 16; ++j) oc[j] += (m == 0 ? 1.f : -lam) * o[j] * il;
        }
        float ss = 0.f;
#pragma unroll
        for (int j = 0; j < 16; ++j) ss += oc[j] * oc[j];
        ss += __shfl_xor(ss, 1); ss += __shfl_xor(ss, 2); ss += __shfl_xor(ss, 4);
        const float rr = rsqrtf(ss * (1.f / 128.f) + EPS) * (1.f - LAMBDA_INIT);
#pragma unroll
        for (int j = 0; j < 16; ++j) { const int e = part * 16 + j; YA[(size_t)(b * SEQ + qb * 64 + qi) * 1024 + h * 128 + e] = (bf16)f2bf(oc[j] * rr * p.subln_g[e]); }
    }
}

__device__ __forceinline__ void n8a(const P& p, LAS float* sm) {
    const bf16* YA = (const bf16*)(p.ws + WS_H); bf16* TMP = (bf16*)(p.ws + WS_D); const float* w = p.w_branch_a;
    ngemm(T, DM, 1024, [=](int m, int k) { return bf2f(YA[(size_t)m * 1024 + k]); }, [=](int k, int n) { return w[(size_t)k * DM + n]; },
          [=](int m, int n, float v) { TMP[(size_t)m * DM + n] = (bf16)f2bf(v); }, sm);
}
__device__ __forceinline__ void n8b(const P& p, LAS float* sm) {
    const bf16* YB = (const bf16*)(p.ws + WS_A); const bf16* TMP = (const bf16*)(p.ws + WS_D); const float* w = p.w_branch_b;
    const bf16* GA = (const bf16*)(p.ws + WS_GA); const bf16* GB = (const bf16*)(p.ws + WS_GB); bf16* MG = (bf16*)(p.ws + WS_MG);
    ngemm(T, DM, 2048, [=](int m, int k) { return bf2f(YB[(size_t)m * 2048 + k]); }, [=](int k, int n) { return w[(size_t)k * DM + n]; },
          [=](int m, int n, float v) { const size_t i = (size_t)m * DM + n; MG[i] = (bf16)f2bf(bf2f(GA[i]) * bf2f(TMP[i]) + bf2f(GB[i]) * v); }, sm);
}
__device__ __forceinline__ void n9(const P& p, LAS float* sm) {
    const bf16* MG = (const bf16*)(p.ws + WS_MG); bf16* MIX = (bf16*)(p.ws + WS_MIX); const float* w = p.w_out; const float* modv = (const float*)(p.ws + WS_MODV);
    ngemm(T, DM, 1024, [=](int m, int k) { return bf2f(MG[(size_t)m * 1024 + k]); }, [=](int k, int n) { return w[(size_t)k * DM + n]; },
          [=](int m, int n, float v) { MIX[(size_t)m * DM + n] = (bf16)f2bf(modv[(m / SEQ) * 6 * DM + 2 * DM + n] * v); }, sm);
}

__device__ __forceinline__ void n10_moe(const P& p, LAS float* sm) {
    const float* modv = (const float*)(p.ws + WS_MODV); const bf16* MIX = (const bf16*)(p.ws + WS_MIX);
    LAS float* h2 = sm;
    LAS float* red = sm + 1024;
    LAS float* sc = sm + 1040;
    LAS float* ch = sm + 1104;
    LAS float* gs = sm + 1168;
    LAS int* sel = (LAS int*)(sm + 1176);
    LAS float* selw = sm + 1184;
    LAS float* act = sm + 1200;
    const int tid = threadIdx.x, lane = tid & 63, wv = tid >> 6;
    for (int t = blockIdx.x; t < T; t += gridDim.x) {
        const int b = t / SEQ;
        __syncthreads();
        float x1[2]; float ss = 0.f;
#pragma unroll
        for (int j = 0; j < 2; ++j) { const int k = tid + 512 * j; x1[j] = p.x[(size_t)t * DM + k] + bf2f(MIX[(size_t)t * DM + k]); ss += x1[j] * x1[j]; }
        ss = block_sum(ss, red);
        const float r = rsqrtf(ss * (1.f / DM) + EPS);
#pragma unroll
        for (int j = 0; j < 2; ++j) { const int k = tid + 512 * j; h2[k] = x1[j] * r * p.norm2_g[k] * (1.f + modv[b * 6 * DM + 4 * DM + k]) + modv[b * 6 * DM + 3 * DM + k]; }
        __syncthreads();
        for (int e = wv * 8; e < wv * 8 + 8; ++e) { float a = 0.f; for (int k = lane; k < DM; k += 64) a += h2[k] * p.w_router[(size_t)k * NEXP + e]; a = wave_sum(a);
            if (lane == 0) { const float s = sigmoidf_(a); sc[e] = s; ch[e] = s + p.router_bias[e]; } }
        __syncthreads();
        if (tid == 0) {
            for (int g = 0; g < 8; ++g) { float m1 = -INFINITY, m2 = -INFINITY; for (int i = 0; i < 8; ++i) { const float v = ch[g * 8 + i]; if (v > m1) { m2 = m1; m1 = v; } else if (v > m2) m2 = v; } gs[g] = m1 + m2; }
            unsigned gmask = 0u;
            for (int k = 0; k < 4; ++k) { int bi = -1; float bv = -INFINITY; for (int g = 0; g < 8; ++g) if (!((gmask >> g) & 1u) && gs[g] > bv) { bv = gs[g]; bi = g; } gmask |= 1u << bi; }
            unsigned long long emask = 0ull; float wsum = 0.f;
            for (int k = 0; k < 8; ++k) { int bi = -1; float bv = -INFINITY; for (int e = 0; e < 64; ++e) if (((gmask >> (e >> 3)) & 1u) && !((emask >> e) & 1ull) && ch[e] > bv) { bv = ch[e]; bi = e; }
                emask |= 1ull << bi; sel[k] = bi; selw[k] = sc[bi]; wsum += sc[bi]; }
            for (int k = 0; k < 8; ++k) selw[k] = selw[k] / wsum * ROUTED_SCALE;
        }
        __syncthreads();
        float y0 = 0.f, y1 = 0.f;
        for (int s = 0; s < 9; ++s) {
            const int e = s < 8 ? sel[s] : 0; const float w = s < 8 ? selw[s] : 1.f;
            const float* Wg = s < 8 ? p.w_exp_gate + (size_t)e * DM * EDIM : p.w_sh_gate;
            const float* Wu = s < 8 ? p.w_exp_up + (size_t)e * DM * EDIM : p.w_sh_up;
            const float* Wd = s < 8 ? p.w_exp_down + (size_t)e * EDIM * DM : p.w_sh_down;
            { const float* W = tid < 256 ? Wg : Wu; const int f = tid & 255; float a = 0.f; for (int k = 0; k < DM; ++k) a += h2[k] * W[(size_t)k * EDIM + f];
              __syncthreads(); if (tid >= 256) act[f] = a; __syncthreads(); if (tid < 256) act[f] = siluf_(a) * act[f] * w; __syncthreads(); }
            for (int f = 0; f < EDIM; ++f) { const float a = act[f]; y0 += a * Wd[(size_t)f * DM + tid]; y1 += a * Wd[(size_t)f * DM + tid + 512]; }
        }
        p.out[(size_t)t * DM + tid] = x1[0] + modv[b * 6 * DM + 5 * DM + tid] * y0;
        p.out[(size_t)t * DM + tid + 512] = x1[1] + modv[b * 6 * DM + 5 * DM + tid + 512] * y1;
    }
}
}
constexpr int LDS_BYTES = 147456;
constexpr int NPH = 13;
#ifndef MK_ONE_LAUNCH
#define MK_ONE_LAUNCH 0
#endif
constexpr int CW_BAR = 4096;

__global__ void __launch_bounds__(NTHR, 2) k_run(P p) {
    extern __shared__ __attribute__((aligned(16))) unsigned char lds[];
    LAS float* sm = (LAS float*)lds;
    volatile LAS unsigned* MISC = (volatile LAS unsigned*)(lds + LDS_BYTES - 64);
    if (threadIdx.x < 16) MISC[threadIdx.x] = 0u;
    __syncthreads();
    XcdBarrier bar; bar.bar = (unsigned*)(p.ws + WS_CTL) + CW_BAR; bar.x = 0; bar.st = nullptr;
    if (MK_ONE_LAUNCH) bar = xcd_barrier_post((unsigned*)(p.ws + WS_CTL) + CW_BAR, MISC + 8);
#define IN(k) (p.ph_lo <= (k) && (k) < p.ph_hi)
#define SEAM(k) do { if (MK_ONE_LAUNCH && IN(k) && IN((k) + 1)) xcd_barrier(bar); } while (0)
    if (IN(0)) { nv::n0_mod_rope(p); } SEAM(0);
    if (IN(1)) { nv::n1_h(p, p.x, nullptr, p.norm1_g, DM, 0, (bf16*)(p.ws + WS_H)); } SEAM(1);
    if (IN(2)) { nv::n2_proj(p, C_Z, INW, sm); } SEAM(2);
    if (IN(3)) { nv::n3_conv(p, (bf16*)(p.ws + WS_C)); } SEAM(3);
    if (IN(4)) { nv::n4_ssd_seq(p, (const bf16*)(p.ws + WS_C), (bf16*)(p.ws + WS_B), sm); } SEAM(4);
    if (IN(5)) { nv::n5_gate_norm(p, (const bf16*)(p.ws + WS_B), (bf16*)(p.ws + WS_A)); } SEAM(5);
    if (IN(6)) { nv::n2_proj(p, 0, C_Z, sm); } SEAM(6);
    if (IN(7)) { nv::n6b_qknorm(p, 0.125f * 1.4426950408889634f); } SEAM(7);
    if (IN(8)) { nv::n7_attn(p, (bf16*)(p.ws + WS_H), sm); } SEAM(8);
    if (IN(9)) { nv::n8a(p, sm); } SEAM(9);
    if (IN(10)) { nv::n8b(p, sm); } SEAM(10);
    if (IN(11)) { nv::n9(p, sm); } SEAM(11);
    if (IN(12)) { nv::n10_moe(p, sm); }
#undef IN
#undef SEAM
}

extern "C" void kernel_launch(void* const* d_in, const int* in_sizes, int n_in, void* d_out, int out_size, void* d_ws, size_t ws_size, hipStream_t stream) {
    static int grid = 0;
    if (grid == 0) {
        if (n_in != 29 || out_size != T * DM || ws_size < WS_END) { fprintf(stderr, "kernel_launch: unexpected shapes (n_in %d out %d ws %zu)\n", n_in, out_size, ws_size); grid = -1; return; }
        int dev = 0, cus = 0;
        if (hipGetDevice(&dev) != hipSuccess || hipDeviceGetAttribute(&cus, hipDeviceAttributeMultiprocessorCount, dev) != hipSuccess) { grid = -1; return; }
        if (hipFuncSetAttribute((const void*)k_run, hipFuncAttributeMaxDynamicSharedMemorySize, LDS_BYTES) != hipSuccess) { grid = -1; return; }
        (void)hipGetLastError();
        grid = cus;
    }
    if (grid < 0) return;
    (void)hipMemsetAsync((char*)d_ws + WS_CTL, 0, CTL_ZERO_BYTES, stream);
    P p{};
    const void** pp = (const void**)&p;
    for (int i = 0; i < 29; ++i) pp[i] = d_in[i];
    p.out = (float*)d_out; p.ws = (unsigned char*)d_ws;
    if (MK_ONE_LAUNCH) { p.ph_lo = 0; p.ph_hi = NPH; hipLaunchKernelGGL(k_run, dim3(grid), dim3(NTHR), LDS_BYTES, stream, p); }
    else for (int k = 0; k < NPH; ++k) { p.ph_lo = k; p.ph_hi = k + 1; hipLaunchKernelGGL(k_run, dim3(grid), dim3(NTHR), LDS_BYTES, stream, p); }
}
```

```cpp
#include <hip/hip_runtime.h>
#include <cstdint>
#include <cstdio>

#define LAS __attribute__((address_space(3)))
#define GAS __attribute__((address_space(1)))
typedef unsigned short bf16;
typedef unsigned v4u __attribute__((ext_vector_type(4)));
typedef unsigned v2u __attribute__((ext_vector_type(2)));
typedef float f32x4 __attribute__((ext_vector_type(4)));
typedef float f32x2 __attribute__((ext_vector_type(2)));
typedef float f32x16 __attribute__((ext_vector_type(16)));
typedef short bf16x8 __attribute__((ext_vector_type(8)));
typedef short s16x4 __attribute__((ext_vector_type(4)));

constexpr int BATCH = 2, SEQ = 8192, DM = 1024, T = BATCH * SEQ;
constexpr int INW = 10272;
constexpr int C_Q = 0, C_K = 1024, C_V = 2048, C_GA = 3072, C_GB = 4096, C_Z = 5120, C_XBC = 7168, C_DT = 10240;
constexpr int NHEAD = 8, HD = 64, VD = 128;
constexpr int SSD_H = 32, SSD_P = 64, SSD_G = 4, SSD_N = 128, SSD_L = 128, SSD_NC = SEQ / SSD_L, CONV_DIM = 3072, DIN = 2048;
constexpr int NEXP = 64, TOPK = 8, EDIM = 256;
constexpr float EPS = 1e-6f;
constexpr float LAMBDA_INIT = 0.2f;
constexpr float ROUTED_SCALE = 2.5f;
constexpr int NTHR = 512, NWAVE = 8;
constexpr float WGU_SCALE = 64.f, WD_SCALE = 32.f, ACT_SCALE = 8.f, WIN_SCALE = 64.f;

constexpr size_t MiB = 1u << 20;
constexpr size_t WS_CTL = 0;
constexpr size_t CTL_ZERO_BYTES = 65536;
constexpr size_t WS_MODV = 1 * MiB;
constexpr size_t WS_DTP = 2 * MiB;
constexpr size_t WS_ROPE = 4 * MiB;
constexpr size_t WS_CD = 8 * MiB;
constexpr size_t WS_PAIRW = 9 * MiB;
constexpr size_t WS_PAIRE = 9 * MiB + 512 * 1024;
constexpr size_t WS_LISTS = 10 * MiB;
constexpr size_t WS_WTA = 14 * MiB, WS_WTB = 16 * MiB, WS_WTOUT = 20 * MiB, WS_WTDT = 22 * MiB;
constexpr size_t WS_H = 24 * MiB;
constexpr size_t WS_A = 56 * MiB;
constexpr size_t WS_B = 120 * MiB;
constexpr size_t WS_C = 216 * MiB;
constexpr size_t WS_D = 280 * MiB;
constexpr size_t WS_WTIN = 312 * MiB;
constexpr size_t WS_END = 332 * MiB;
constexpr size_t WS_H8 = 280 * MiB, WS_WTIN8 = 296 * MiB;
constexpr size_t WS_SH = 297 * MiB;
constexpr size_t WS_Q = WS_B, WS_K = WS_B + 32 * MiB, WS_V = WS_B + 64 * MiB;
constexpr size_t WS_GA = WS_A, WS_GB = WS_A + 32 * MiB;
constexpr size_t WS_YB = WS_C;
constexpr size_t WS_MG = 120 * MiB;
constexpr size_t WS_MIX = WS_H;
constexpr size_t WS_ACT = 56 * MiB;
constexpr size_t WS_WTD = 136 * MiB;
constexpr size_t WS_WTGU = 169 * MiB;
constexpr size_t WS_H2 = 234 * MiB;
constexpr size_t WS_Y = 169 * MiB;
constexpr size_t WS_LW = 4 * MiB;

__device__ __forceinline__ unsigned f2bf(float f) { unsigned u = __builtin_bit_cast(unsigned, f); return (u + 0x7fffu + ((u >> 16) & 1u)) >> 16; }
__device__ __forceinline__ float bf2f(unsigned h) { return __builtin_bit_cast(float, (h & 0xffffu) << 16); }
__device__ __forceinline__ unsigned pk2(float lo, float hi) { return f2bf(lo) | (f2bf(hi) << 16); }
__device__ __forceinline__ float sigmoidf_(float x) { return 1.f / (1.f + __expf(-x)); }
__device__ __forceinline__ float siluf_(float x) { return x / (1.f + __expf(-x)); }
__device__ __forceinline__ float softplusf_(float x) { return x > 20.f ? x : log1pf(__expf(x)); }
__device__ __forceinline__ float wave_sum(float v) {
#pragma unroll
    for (int o = 1; o < 64; o <<= 1) v += __shfl_xor(v, o);
    return v;
}
__device__ __forceinline__ float block_sum(float v, LAS float* red) {
    v = wave_sum(v);
    __syncthreads();
    if ((threadIdx.x & 63) == 0) red[threadIdx.x >> 6] = v;
    __syncthreads();
    float s = 0.f;
#pragma unroll
    for (int i = 0; i < NWAVE; ++i) s += red[i];
    return s;
}

struct P;
typedef const __attribute__((address_space(4))) P* KP;
struct P {
    const float* x; const float* c; const int* positions; const float* w_ada; const float* b_ada; const float* norm1_g; const float* w_in;
    const float* q_norm_g; const float* k_norm_g; const float* lambda_qk; const float* subln_g; const float* conv_w; const float* conv_b;
    const float* dt_bias; const float* a_log; const float* d_skip; const float* ssd_norm_g; const float* w_branch_a; const float* w_branch_b;
    const float* w_out; const float* norm2_g; const float* w_router; const float* router_bias; const float* w_exp_gate; const float* w_exp_up;
    const float* w_exp_down; const float* w_sh_gate; const float* w_sh_up; const float* w_sh_down;
    float* out; unsigned char* ws; int ph_lo, ph_hi;
};
#define XB_TMO      128
#define XB_XCNT(j)  (256  + 64 * (j))
#define XB_XSUB(j)  (1280 + 64 * (j))
#define XB_XGEN(j)  (2304 + 64 * (j))
#define XB_TOP      3328
#define XB_TOPGEN   3392
#define XCD_BAR_WORDS 3456
#define XB_SPIN_CAP (1u << 23)

__device__ __forceinline__ unsigned xb_ld(unsigned* p)              { return __hip_atomic_load(p, __ATOMIC_RELAXED, __HIP_MEMORY_SCOPE_AGENT); }
__device__ __forceinline__ unsigned xb_add(unsigned* p, unsigned v) { return __hip_atomic_fetch_add(p, v, __ATOMIC_RELAXED, __HIP_MEMORY_SCOPE_AGENT); }
__device__ __forceinline__ unsigned xb_xcc_id() { return (unsigned)__builtin_amdgcn_s_getreg((3 << 11) | 20) & 0xFu; }
#define XB_SPIN(cond, bar) do { unsigned _sp = 0; while (cond) { __builtin_amdgcn_s_sleep(1); \
    if ((++_sp & 255u) == 0u) { if (xb_ld(&(bar)[XB_TMO])) break; if (_sp > XB_SPIN_CAP) { atomicAdd(&(bar)[XB_TMO], 1u); break; } } } } while (0)

struct XcdBarrier {
    unsigned* bar; unsigned x;
    volatile LAS unsigned* st;
};

__device__ __forceinline__ XcdBarrier xcd_barrier_post(unsigned* bar, volatile LAS unsigned* st) {
    XcdBarrier b; b.bar = bar; b.x = xb_xcc_id(); b.st = st;
    if (threadIdx.x == 0) (void)xb_add(&bar[XB_XCNT(b.x)], 1u);
    return b;
}
__device__ __forceinline__ void xcd_barrier_complete(unsigned* bar, unsigned x, unsigned& nloc, unsigned& nx) {
    const unsigned G = gridDim.x * gridDim.y * gridDim.z;
    unsigned sum, cnt, mine, sp = 0u;
    for (;;) {
        sum = 0u; cnt = 0u; mine = 0u;
#pragma unroll
        for (unsigned j = 0; j < 16; ++j) { const unsigned c = xb_ld(&bar[XB_XCNT(j)]); sum += c; cnt += (c > 0u) ? 1u : 0u; mine = (j == x) ? c : mine; }
        if (sum == G) break;
        __builtin_amdgcn_s_sleep(1);
        if ((++sp & 255u) == 0u) { if (xb_ld(&bar[XB_TMO])) break; if (sp > XB_SPIN_CAP) { atomicAdd(&bar[XB_TMO], 1u); break; } }
    }
    nloc = mine > 0u ? mine : 1u; nx = cnt > 0u ? cnt : 1u;
}

__device__ __forceinline__ void xcd_barrier(const XcdBarrier& b) {
    asm volatile("s_waitcnt vmcnt(0)" ::: "memory");
    __syncthreads();
    if (threadIdx.x == 0) {
        unsigned* bar = b.bar;
        __builtin_amdgcn_s_waitcnt(0);
        unsigned nloc = b.st[0], nx = b.st[1];
        if (nloc == 0u) { xcd_barrier_complete(bar, b.x, nloc, nx); b.st[0] = nloc; b.st[1] = nx; }
        const unsigned old = xb_add(&bar[XB_XSUB(b.x)], 1u);
        const unsigned gen = old / nloc;
        if (old + 1u == (gen + 1u) * nloc) {
            __builtin_amdgcn_fence(__ATOMIC_RELEASE, "agent");
            asm volatile("s_waitcnt vmcnt(0)" ::: "memory");
            const unsigned og = xb_add(&bar[XB_TOP], 1u);
            const unsigned tg = og / nx;
            if (og + 1u == (tg + 1u) * nx) xb_add(&bar[XB_TOPGEN], 1u);
            else XB_SPIN(xb_ld(&bar[XB_TOPGEN]) == tg, bar);
            __builtin_amdgcn_fence(__ATOMIC_ACQUIRE, "agent");
            xb_add(&bar[XB_XGEN(b.x)], 1u);
            asm volatile("s_waitcnt vmcnt(0)" ::: "memory");
        } else {
            XB_SPIN(xb_ld(&bar[XB_XGEN(b.x)]) == gen, bar);
            __builtin_amdgcn_fence(__ATOMIC_ACQUIRE, "agent");
            asm volatile("s_waitcnt vmcnt(0)" ::: "memory");
        }
    }
    __syncthreads();
}

__device__ __forceinline__ void xcd_barrier_arrive(const XcdBarrier& b) {
    struct { unsigned gen, tg; int role; } t; t.gen = 0u; t.tg = 0u; t.role = 0;
    asm volatile("s_waitcnt vmcnt(0)" ::: "memory");
    __syncthreads();
    if (threadIdx.x == 0) {
        unsigned* bar = b.bar;
        __builtin_amdgcn_s_waitcnt(0);
        unsigned nloc = b.st[0], nx = b.st[1];
        if (nloc == 0u) { xcd_barrier_complete(bar, b.x, nloc, nx); b.st[0] = nloc; b.st[1] = nx; }
        const unsigned old = xb_add(&bar[XB_XSUB(b.x)], 1u);
        t.gen = old / nloc;
        if (old + 1u == (t.gen + 1u) * nloc) {
            __builtin_amdgcn_fence(__ATOMIC_RELEASE, "agent");
            asm volatile("s_waitcnt vmcnt(0)" ::: "memory");
            const unsigned og = xb_add(&bar[XB_TOP], 1u);
            t.tg = og / nx;
            if (og + 1u == (t.tg + 1u) * nx) { xb_add(&bar[XB_TOPGEN], 1u); t.role = 2; } else t.role = 1;
        }
        b.st[2] = t.gen; b.st[3] = t.tg; b.st[4] = (unsigned)t.role;
    }
}
__device__ __forceinline__ void xcd_barrier_wait(const XcdBarrier& b) {
    if (threadIdx.x == 0) {
        unsigned* bar = b.bar;
        struct { unsigned gen, tg; int role; } t; t.gen = b.st[2]; t.tg = b.st[3]; t.role = (int)b.st[4];
        if (t.role != 0) {
            if (t.role == 1) XB_SPIN(xb_ld(&bar[XB_TOPGEN]) == t.tg, bar);
            __builtin_amdgcn_fence(__ATOMIC_ACQUIRE, "agent");
            xb_add(&bar[XB_XGEN(b.x)], 1u);
            asm volatile("s_waitcnt vmcnt(0)" ::: "memory");
        } else {
            XB_SPIN(xb_ld(&bar[XB_XGEN(b.x)]) == t.gen, bar);
            __builtin_amdgcn_fence(__ATOMIC_ACQUIRE, "agent");
            asm volatile("s_waitcnt vmcnt(0)" ::: "memory");
        }
    }
    __syncthreads();
}

namespace pg8 {
#define PG8_LAS __attribute__((address_space(3)))
typedef unsigned short bf16_t;
typedef short bf16x8 __attribute__((ext_vector_type(8)));
typedef float f32x4 __attribute__((ext_vector_type(4)));
typedef unsigned u32x4 __attribute__((ext_vector_type(4)));
typedef int i32x4 __attribute__((ext_vector_type(4)));
constexpr int BM = 256, BK = 64, HALF = 128, HTB = HALF * BK * 2  , STAGE_BYTES = 8 * HTB, NXCD = 8, WGM = 8;

__host__ __device__ __forceinline__ int lds_byte(int r, int c) { const int st = (r >> 4) * 2 + (c >> 5), rr = r & 15, cc = c & 31, ob = rr * 64 + cc * 2; return st * 1024 + (ob ^ (((ob >> 9) & 1) << 5)); }
__host__ __device__ __forceinline__ void stage_rc(int b, int& R, int& C) { const int st = b / 1024, sb = b % 1024, swz = sb ^ (((sb >> 9) & 1) << 5); R = (st >> 1) * 16 + swz / 64; C = (st & 1) * 32 + (swz % 64) / 2; }
__host__ __device__ __forceinline__ int perm32(int rho) { const int n = rho >> 4, i = rho & 15; return 8 * (i >> 2) + 4 * n + (i & 3); }

struct Unit { int pm, pn; };
struct Gemm { const bf16_t* A; const bf16_t* Bt; int M, N, K; };

struct StaticOrder {
    int nM, nN, nwg, G, c;
    __host__ __device__ __forceinline__ void init(int M, int N, int G_, int c_) { nM = M / BM; nN = N / BM; nwg = nM * nN; G = G_; c = c_; }
    __host__ __device__ __forceinline__ bool next(int i, Unit& u) const {
        const long L = (long)i * G + c; if (L >= nwg) return false;
        int wgid = (int)L; { const int q = nwg / NXCD, r = nwg % NXCD, xcd = wgid % NXCD, off = wgid / NXCD; wgid = (xcd < r ? xcd * (q + 1) : r * (q + 1) + (xcd - r) * q) + off; }
        const int nig = WGM * nN, gid = wgid / nig, fm = gid * WGM, gsz = (nM - fm) < WGM ? (nM - fm) : WGM;
        u.pm = fm + ((wgid % nig) % gsz); u.pn = (wgid % nig) / gsz; return true;
    }
    __device__ __forceinline__ void a_ready(const Unit&) const {}
    __device__ __forceinline__ void done(const Unit&) const {}
};

__device__ __forceinline__ unsigned cvt_pk_bf16(float lo, float hi) { unsigned r; asm volatile("v_cvt_pk_bf16_f32 %0, %1, %2" : "=v"(r) : "v"(lo), "v"(hi)); return r; }
typedef float f32x2 __attribute__((ext_vector_type(2)));
__device__ __forceinline__ f32x2 gelu_pk(f32x2 v) {
    const f32x2 av = __builtin_elementwise_abs(v), d = av * 0.2316418882f + 1.0f;
    f32x2 t; t.x = __builtin_amdgcn_rcpf(d.x); t.y = __builtin_amdgcn_rcpf(d.y);
    f32x2 q = t * 0.5307027145f + (-0.7265760135f); q = q * t + 0.7107068705f; q = q * t + (-0.142248368f); q = q * t + 0.127414796f; q = q * t;
    const f32x2 s = (v * v) * (-0.72134752044f);
    f32x2 e; e.x = __builtin_amdgcn_exp2f(s.x); e.y = __builtin_amdgcn_exp2f(s.y);
    const f32x2 m = v * (q * e), r = v - m;
    f32x2 o; o.x = v.x < 0.f ? m.x : r.x; o.y = v.y < 0.f ? m.y : r.y; return o;
}

template <int ACT  > struct EpiBf16 {
    static constexpr bool PERM = true, AFTER_DRAIN = false; static_assert(ACT == 0 || ACT == 1, "EpiBf16: ACT is 0 (none) or 1 (gelu_pk)");
    bf16_t* O; int ldc; const float* bias; int split_cols; size_t split_stride; float scale0;
    __device__ __forceinline__ void operator()(const f32x4 (&acc)[2][2][4][2], const Unit& u, int wr, int wc, int fr, int fq) const {
        const int row0 = u.pm * BM + wr * 64 + fr; int colt = u.pn * BM; bf16_t* base = O;
        float sc = 1.f; if (split_cols) { const int t = colt / split_cols; base += (size_t)t * split_stride; colt -= t * split_cols; if (t == 0) sc = scale0; }
        const int col0 = colt + wc * 32 + 8 * fq, bcol0 = u.pn * BM + wc * 32 + 8 * fq;
        f32x4 bv[2][2];
#pragma unroll
        for (int bj = 0; bj < 2; ++bj)
#pragma unroll
            for (int n = 0; n < 2; ++n) bv[bj][n] = bias ? *(const f32x4*)(bias + bcol0 + bj * HALF + 4 * n) : (f32x4){0.f, 0.f, 0.f, 0.f};
#pragma unroll
        for (int ai = 0; ai < 2; ++ai)
#pragma unroll
            for (int m = 0; m < 4; ++m) { bf16_t* rowp = base + (size_t)(row0 + ai * HALF + m * 16) * ldc + col0;
#pragma unroll
                for (int bj = 0; bj < 2; ++bj) { f32x4 v0 = acc[ai][bj][m][0] + bv[bj][0], v1 = acc[ai][bj][m][1] + bv[bj][1];
                    if (ACT == 1) { f32x2 a = gelu_pk((f32x2){v0[0], v0[1]}), b = gelu_pk((f32x2){v0[2], v0[3]}), c = gelu_pk((f32x2){v1[0], v1[1]}), d = gelu_pk((f32x2){v1[2], v1[3]});
                        v0 = (f32x4){a.x, a.y, b.x, b.y}; v1 = (f32x4){c.x, c.y, d.x, d.y}; }
                    v0 = v0 * sc; v1 = v1 * sc; u32x4 w; w.x = cvt_pk_bf16(v0[0], v0[1]); w.y = cvt_pk_bf16(v0[2], v0[3]); w.z = cvt_pk_bf16(v1[0], v1[1]); w.w = cvt_pk_bf16(v1[2], v1[3]);
                    *(u32x4*)(rowp + bj * HALF) = w; } }
    }
};
template <class Epi, class Sched, bool ALIGN_EPI = false, bool SP2 = false, bool FP8 = false>
__device__ __forceinline__ void gemm_phase(PG8_LAS unsigned char* lds, const Gemm g, const Sched& S, const Epi& E) {
    const int tid = threadIdx.x, wid = __builtin_amdgcn_readfirstlane(tid >> 6), lane = tid & 63, wr = wid >> 2, wc = wid & 3, fr = lane & 15, fq = lane >> 4;
    const int K = g.K, nt = K / BK;
    unsigned voffA[2], voffB[2];
#pragma unroll
    for (int i = 0; i < 2; ++i) { int R, C; stage_rc(tid * 16 + i * 8192, R, C); const int Rb = Epi::PERM ? ((R & ~31) + perm32(R & 31)) : R;
        voffA[i] = (unsigned)(R * K + C) * 2u; voffB[i] = (unsigned)(Rb * K + C) * 2u; }
    const size_t kstep = (size_t)(BK * 2);
    const size_t hstep = (size_t)HALF * K * 2;
    const size_t tstep = 2 * hstep;
    const unsigned ldsw = (unsigned)wid * 1024u;
    const int aoff = lds_byte(wr * 64 + fr, fq * 8), boff = lds_byte(wc * 32 + fr, fq * 8);
#define PG8_SA(b, h) (((b) * 2 + (h)) * HTB)
#define PG8_SB(b, h) ((4 + (b) * 2 + (h)) * HTB)
#define PG8_STAGE(bufoff, gbase, voff) do { _Pragma("unroll") for (int _i = 0; _i < 2; ++_i) \
        __builtin_amdgcn_global_load_lds((const unsigned*)((const char*)(gbase) + (voff)[_i]), (PG8_LAS unsigned*)(lds + (bufoff) + ldsw + _i * 8192), 16, 0, 0); } while (0)
#define PG8_LDA(dst, b, h) do { _Pragma("unroll") for (int m = 0; m < 4; ++m) _Pragma("unroll") for (int k = 0; k < 2; ++k) dst[m][k] = *(const PG8_LAS bf16x8*)(lds + PG8_SA(b, h) + aoff + m * 2048 + k * 1024); } while (0)
#define PG8_LDB(dst, b, h) do { _Pragma("unroll") for (int n = 0; n < 2; ++n) _Pragma("unroll") for (int k = 0; k < 2; ++k) dst[n][k] = *(const PG8_LAS bf16x8*)(lds + PG8_SB(b, h) + boff + n * 2048 + k * 1024); } while (0)
#define PG8_CAT(x, y) __builtin_shufflevector(__builtin_bit_cast(i32x4, x), __builtin_bit_cast(i32x4, y), 0, 1, 2, 3, 4, 5, 6, 7)
#define PG8_MMA(ai, bj, At, Bt) do { __builtin_amdgcn_s_setprio(1); \
        if constexpr (FP8) { _Pragma("unroll") for (int m = 0; m < 4; ++m) _Pragma("unroll") for (int n = 0; n < 2; ++n) \
            acc[ai][bj][m][n] = __builtin_amdgcn_mfma_scale_f32_16x16x128_f8f6f4(PG8_CAT(Bt[n][0], Bt[n][1]), PG8_CAT(At[m][0], At[m][1]), acc[ai][bj][m][n], 0, 0, 0, 0x7f7f7f7f, 0, 0x7f7f7f7f); } \
        else { _Pragma("unroll") for (int m = 0; m < 4; ++m) _Pragma("unroll") for (int n = 0; n < 2; ++n) _Pragma("unroll") for (int k = 0; k < 2; ++k) \
            acc[ai][bj][m][n] = __builtin_amdgcn_mfma_f32_16x16x32_bf16(Bt[n][k], At[m][k], acc[ai][bj][m][n], 0, 0, 0); } \
        __builtin_amdgcn_s_setprio(0); } while (0)
#define PG8_WAIT_V(n) asm volatile("s_waitcnt vmcnt(" #n ")" ::: "memory")
#define PG8_WAIT_L(n) asm volatile("s_waitcnt lgkmcnt(" #n ")" ::: "memory")
#define PG8_BAR __builtin_amdgcn_s_barrier()
#define PG8_SCHED __builtin_amdgcn_sched_barrier(0)
    Unit cur, nxt; int ui = 0;
    if (!S.next(0, cur)) return;
    f32x4 acc[2][2][4][2];
#pragma unroll
    for (int a = 0; a < 2; ++a)
#pragma unroll
        for (int b = 0; b < 2; ++b)
#pragma unroll
            for (int m = 0; m < 4; ++m)
#pragma unroll
                for (int n = 0; n < 2; ++n) acc[a][b][m][n] = (f32x4){0.f, 0.f, 0.f, 0.f};
    bf16x8 At[4][2], B0[2][2], B1[2][2];
    const char* cA = (const char*)g.A + (size_t)cur.pm * tstep; const char* cB = (const char*)g.Bt + (size_t)cur.pn * tstep;
    S.a_ready(cur);
    if constexpr (SP2) {
        PG8_STAGE(PG8_SB(0, 0), cB, voffB); PG8_STAGE(PG8_SB(0, 1), cB + hstep, voffB); PG8_STAGE(PG8_SA(0, 0), cA, voffA); PG8_STAGE(PG8_SA(0, 1), cA + hstep, voffA);
        if (wr == 1) PG8_BAR;
        PG8_WAIT_V(2); PG8_BAR;
        PG8_STAGE(PG8_SB(1, 0), cB + kstep, voffB); PG8_STAGE(PG8_SA(1, 0), cA + kstep, voffA); PG8_STAGE(PG8_SB(1, 1), cB + hstep + kstep, voffB);
        PG8_WAIT_V(6); PG8_BAR;
    } else {
        PG8_STAGE(PG8_SB(0, 0), cB, voffB); PG8_STAGE(PG8_SA(0, 0), cA, voffA); PG8_STAGE(PG8_SB(0, 1), cB + hstep, voffB); PG8_STAGE(PG8_SA(0, 1), cA + hstep, voffA);
        if (wr == 1) PG8_BAR;
        PG8_WAIT_V(4); PG8_BAR;
        PG8_STAGE(PG8_SB(1, 0), cB + kstep, voffB); PG8_STAGE(PG8_SA(1, 0), cA + kstep, voffA); PG8_STAGE(PG8_SB(1, 1), cB + hstep + kstep, voffB);
        PG8_WAIT_V(6); PG8_BAR;
    }
    for (;;) {
        const bool has_next = S.next(ui + 1, nxt);
        const char* nA = has_next ? (const char*)g.A + (size_t)nxt.pm * tstep : cA; const char* nB = has_next ? (const char*)g.Bt + (size_t)nxt.pn * tstep : cB;
#pragma unroll 1
        for (int t = 0; t < nt; t += 2) {
            const bool last = (t == nt - 2);
            const char* a1 = cA + (size_t)(t + 1) * kstep;
            const char* a2 = last ? nA : cA + (size_t)(t + 2) * kstep; const char* b2 = last ? nB : cB + (size_t)(t + 2) * kstep;
            const char* a3 = a2 + kstep; const char* b3 = b2 + kstep;
            if (last && has_next) S.a_ready(nxt);
            if constexpr (SP2) {
            PG8_LDB(B0, 0, 0); PG8_LDB(B1, 0, 1); PG8_SCHED; PG8_LDA(At, 0, 0); PG8_STAGE(PG8_SA(1, 1), a1 + hstep, voffA);
            PG8_WAIT_V(8); PG8_WAIT_L(0); PG8_BAR; PG8_MMA(0, 0, At, B0); PG8_MMA(0, 1, At, B1); PG8_BAR; PG8_SCHED;
            PG8_LDA(At, 0, 1); PG8_STAGE(PG8_SB(0, 0), b2, voffB); PG8_STAGE(PG8_SB(0, 1), b2 + hstep, voffB); PG8_STAGE(PG8_SA(0, 0), a2, voffA);
            PG8_WAIT_V(8); PG8_WAIT_L(0); PG8_BAR; PG8_MMA(1, 0, At, B0); PG8_MMA(1, 1, At, B1); PG8_BAR; PG8_SCHED;
            PG8_LDB(B0, 1, 0); PG8_LDB(B1, 1, 1); PG8_SCHED; PG8_LDA(At, 1, 0); PG8_STAGE(PG8_SA(0, 1), a2 + hstep, voffA);
            PG8_WAIT_V(8); PG8_WAIT_L(0); PG8_BAR; PG8_MMA(0, 0, At, B0); PG8_MMA(0, 1, At, B1); PG8_BAR; PG8_SCHED;
            PG8_LDA(At, 1, 1); PG8_STAGE(PG8_SB(1, 0), b3, voffB); PG8_STAGE(PG8_SB(1, 1), b3 + hstep, voffB); PG8_STAGE(PG8_SA(1, 0), a3, voffA);
            PG8_WAIT_V(8); PG8_WAIT_L(0); PG8_BAR; PG8_MMA(1, 0, At, B0); PG8_MMA(1, 1, At, B1); PG8_BAR; PG8_SCHED;
            } else {
            PG8_LDB(B0, 0, 0); PG8_SCHED; PG8_LDA(At, 0, 0); PG8_STAGE(PG8_SA(1, 1), a1 + hstep, voffA);
            PG8_WAIT_L(8); PG8_BAR; PG8_WAIT_L(0); PG8_MMA(0, 0, At, B0); PG8_BAR; PG8_SCHED;
            PG8_LDB(B1, 0, 1); PG8_STAGE(PG8_SB(0, 0), b2, voffB);
            PG8_BAR; PG8_WAIT_L(0); PG8_MMA(0, 1, At, B1); PG8_BAR;
            PG8_LDA(At, 0, 1); PG8_STAGE(PG8_SA(0, 0), a2, voffA);
            PG8_BAR; PG8_WAIT_L(0); PG8_MMA(1, 0, At, B0); PG8_BAR; PG8_SCHED;
            PG8_STAGE(PG8_SB(0, 1), b2 + hstep, voffB);
            PG8_WAIT_V(6); PG8_BAR; PG8_MMA(1, 1, At, B1); PG8_BAR;
            PG8_LDB(B0, 1, 0); PG8_SCHED; PG8_LDA(At, 1, 0); PG8_STAGE(PG8_SA(0, 1), a2 + hstep, voffA);
            PG8_WAIT_L(8); PG8_BAR; PG8_WAIT_L(0); PG8_MMA(0, 0, At, B0); PG8_BAR; PG8_SCHED;
            PG8_LDB(B1, 1, 1); PG8_STAGE(PG8_SB(1, 0), b3, voffB);
            PG8_BAR; PG8_WAIT_L(0); PG8_MMA(0, 1, At, B1); PG8_BAR;
            PG8_LDA(At, 1, 1); PG8_STAGE(PG8_SA(1, 0), a3, voffA);
            PG8_BAR; PG8_WAIT_L(0); PG8_MMA(1, 0, At, B0); PG8_BAR; PG8_SCHED;
            PG8_STAGE(PG8_SB(1, 1), b3 + hstep, voffB);
            PG8_WAIT_V(6); PG8_BAR; PG8_MMA(1, 1, At, B1); PG8_BAR;
            }
        }
        if constexpr (ALIGN_EPI) { if (wr == 0) PG8_BAR; }
        if constexpr (!Epi::AFTER_DRAIN) { E(acc, cur, wr, wc, fr, fq); S.done(cur); }
        if (!has_next) break;
#pragma unroll
        for (int a = 0; a < 2; ++a)
#pragma unroll
            for (int b = 0; b < 2; ++b)
#pragma unroll
                for (int m = 0; m < 4; ++m)
#pragma unroll
                    for (int n = 0; n < 2; ++n) acc[a][b][m][n] = (f32x4){0.f, 0.f, 0.f, 0.f};
        cur = nxt; cA = nA; cB = nB; ++ui;
        if constexpr (ALIGN_EPI) { if (wr == 1) PG8_BAR; }
    }
    PG8_WAIT_V(0);
    if constexpr (!ALIGN_EPI) { if (wr == 0) PG8_BAR; }
    PG8_BAR;
    if constexpr (Epi::AFTER_DRAIN) { E.fused(acc, cur, wr, wc, fr, fq, lds, wid, lane); S.done(cur); }
#undef PG8_SA
#undef PG8_SB
#undef PG8_STAGE
#undef PG8_LDA
#undef PG8_LDB
#undef PG8_MMA
#undef PG8_CAT
#undef PG8_WAIT_V
#undef PG8_WAIT_L
#undef PG8_BAR
#undef PG8_SCHED
}
}
namespace pg8 {
template <class Epi, class Sched, bool FP8 = false>
__device__ __forceinline__ void gemm_phase_gather(PG8_LAS unsigned char* lds, const Gemm g, const Sched& S, const Epi& E, const PG8_LAS int* tokl) {
    constexpr bool ALIGN_EPI = true, SP2 = true;
    const int tid = threadIdx.x, wid = __builtin_amdgcn_readfirstlane(tid >> 6), lane = tid & 63, wr = wid >> 2, wc = wid & 3, fr = lane & 15, fq = lane >> 4;
    const int K = g.K, nt = K / BK;
    unsigned voffB[2];
#pragma unroll
    for (int i = 0; i < 2; ++i) { int R, C; stage_rc(tid * 16 + i * 8192, R, C); const int Rb = Epi::PERM ? ((R & ~31) + perm32(R & 31)) : R;
        voffB[i] = (unsigned)(Rb * K + C) * 2u; }
    unsigned va0[2], va1[2]; const unsigned voffA[2] = {0u, 0u};
#define PG8_VOFF(ui_, d0, d1) do { _Pragma("unroll") for (int _i = 0; _i < 2; ++_i) { int R_, C_; stage_rc(tid * 16 + _i * 8192, R_, C_); d0[_i] = (unsigned)(tokl[(ui_) * 256 + R_] * K + C_) * 2u; d1[_i] = (unsigned)(tokl[(ui_) * 256 + 128 + R_] * K + C_) * 2u; } } while (0)
    const size_t kstep = (size_t)(BK * 2);
    const size_t hstep = (size_t)HALF * K * 2;
    const size_t tstep = 2 * hstep;
    const unsigned ldsw = (unsigned)wid * 1024u;
    const int aoff = lds_byte(wr * 64 + fr, fq * 8), boff = lds_byte(wc * 32 + fr, fq * 8);
#define PG8_SA(b, h) (((b) * 2 + (h)) * HTB)
#define PG8_SB(b, h) ((4 + (b) * 2 + (h)) * HTB)
#define PG8_STAGE(bufoff, gbase, voff) do { _Pragma("unroll") for (int _i = 0; _i < 2; ++_i) \
        __builtin_amdgcn_global_load_lds((const unsigned*)((const char*)(gbase) + (voff)[_i]), (PG8_LAS unsigned*)(lds + (bufoff) + ldsw + _i * 8192), 16, 0, 0); } while (0)
#define PG8_LDA(dst, b, h) do { _Pragma("unroll") for (int m = 0; m < 4; ++m) _Pragma("unroll") for (int k = 0; k < 2; ++k) dst[m][k] = *(const PG8_LAS bf16x8*)(lds + PG8_SA(b, h) + aoff + m * 2048 + k * 1024); } while (0)
#define PG8_LDB(dst, b, h) do { _Pragma("unroll") for (int n = 0; n < 2; ++n) _Pragma("unroll") for (int k = 0; k < 2; ++k) dst[n][k] = *(const PG8_LAS bf16x8*)(lds + PG8_SB(b, h) + boff + n * 2048 + k * 1024); } while (0)
#define PG8_CAT(x, y) __builtin_shufflevector(__builtin_bit_cast(i32x4, x), __builtin_bit_cast(i32x4, y), 0, 1, 2, 3, 4, 5, 6, 7)
#define PG8_MMA(ai, bj, At, Bt) do { __builtin_amdgcn_s_setprio(1); \
        if constexpr (FP8) { _Pragma("unroll") for (int m = 0; m < 4; ++m) _Pragma("unroll") for (int n = 0; n < 2; ++n) \
            acc[ai][bj][m][n] = __builtin_amdgcn_mfma_scale_f32_16x16x128_f8f6f4(PG8_CAT(Bt[n][0], Bt[n][1]), PG8_CAT(At[m][0], At[m][1]), acc[ai][bj][m][n], 0, 0, 0, 0x7f7f7f7f, 0, 0x7f7f7f7f); } \
        else { _Pragma("unroll") for (int m = 0; m < 4; ++m) _Pragma("unroll") for (int n = 0; n < 2; ++n) _Pragma("unroll") for (int k = 0; k < 2; ++k) \
            acc[ai][bj][m][n] = __builtin_amdgcn_mfma_f32_16x16x32_bf16(Bt[n][k], At[m][k], acc[ai][bj][m][n], 0, 0, 0); } \
        __builtin_amdgcn_s_setprio(0); } while (0)
#define PG8_WAIT_V(n) asm volatile("s_waitcnt vmcnt(" #n ")" ::: "memory")
#define PG8_WAIT_L(n) asm volatile("s_waitcnt lgkmcnt(" #n ")" ::: "memory")
#define PG8_BAR __builtin_amdgcn_s_barrier()
#define PG8_SCHED __builtin_amdgcn_sched_barrier(0)
    Unit cur, nxt; int ui = 0;
    if (!S.next(0, cur)) return;
    f32x4 acc[2][2][4][2];
#pragma unroll
    for (int a = 0; a < 2; ++a)
#pragma unroll
        for (int b = 0; b < 2; ++b)
#pragma unroll
            for (int m = 0; m < 4; ++m)
#pragma unroll
                for (int n = 0; n < 2; ++n) acc[a][b][m][n] = (f32x4){0.f, 0.f, 0.f, 0.f};
    bf16x8 At[4][2], B0[2][2], B1[2][2];
    const char* cA = (const char*)g.A; const char* cB = (const char*)g.Bt + (size_t)cur.pn * tstep;
    PG8_VOFF(0, va0, va1);
    S.a_ready(cur);
    if constexpr (SP2) {
        PG8_STAGE(PG8_SB(0, 0), cB, voffB); PG8_STAGE(PG8_SB(0, 1), cB + hstep, voffB); PG8_STAGE(PG8_SA(0, 0), cA, va0); PG8_STAGE(PG8_SA(0, 1), cA, va1);
        if (wr == 1) PG8_BAR;
        PG8_WAIT_V(2); PG8_BAR;
        PG8_STAGE(PG8_SB(1, 0), cB + kstep, voffB); PG8_STAGE(PG8_SA(1, 0), cA + kstep, va0); PG8_STAGE(PG8_SB(1, 1), cB + hstep + kstep, voffB);
        PG8_WAIT_V(6); PG8_BAR;
    } else {
        PG8_STAGE(PG8_SB(0, 0), cB, voffB); PG8_STAGE(PG8_SA(0, 0), cA, voffA); PG8_STAGE(PG8_SB(0, 1), cB + hstep, voffB); PG8_STAGE(PG8_SA(0, 1), cA + hstep, voffA);
        if (wr == 1) PG8_BAR;
        PG8_WAIT_V(4); PG8_BAR;
        PG8_STAGE(PG8_SB(1, 0), cB + kstep, voffB); PG8_STAGE(PG8_SA(1, 0), cA + kstep, voffA); PG8_STAGE(PG8_SB(1, 1), cB + hstep + kstep, voffB);
        PG8_WAIT_V(6); PG8_BAR;
    }
    for (;;) {
        const bool has_next = S.next(ui + 1, nxt);
        const char* nA = cA; const char* nB = has_next ? (const char*)g.Bt + (size_t)nxt.pn * tstep : cB;
#pragma unroll 1
        for (int t = 0; t < nt; t += 2) {
            const bool last = (t == nt - 2);
            const char* a1 = cA + (size_t)(t + 1) * kstep;
            const char* a2 = last ? nA : cA + (size_t)(t + 2) * kstep; const char* b2 = last ? nB : cB + (size_t)(t + 2) * kstep;
            const char* a3 = a2 + kstep; const char* b3 = b2 + kstep;
            if (last && has_next) S.a_ready(nxt);
            if constexpr (SP2) {
            PG8_LDB(B0, 0, 0); PG8_LDB(B1, 0, 1); PG8_SCHED; PG8_LDA(At, 0, 0); PG8_STAGE(PG8_SA(1, 1), a1, va1);
            if (last && has_next) PG8_VOFF(ui + 1, va0, va1);
            PG8_WAIT_V(8); PG8_WAIT_L(0); PG8_BAR; PG8_MMA(0, 0, At, B0); PG8_MMA(0, 1, At, B1); PG8_BAR; PG8_SCHED;
            PG8_LDA(At, 0, 1); PG8_STAGE(PG8_SB(0, 0), b2, voffB); PG8_STAGE(PG8_SB(0, 1), b2 + hstep, voffB); PG8_STAGE(PG8_SA(0, 0), a2, va0);
            PG8_WAIT_V(8); PG8_WAIT_L(0); PG8_BAR; PG8_MMA(1, 0, At, B0); PG8_MMA(1, 1, At, B1); PG8_BAR; PG8_SCHED;
            PG8_LDB(B0, 1, 0); PG8_LDB(B1, 1, 1); PG8_SCHED; PG8_LDA(At, 1, 0); PG8_STAGE(PG8_SA(0, 1), a2, va1);
            PG8_WAIT_V(8); PG8_WAIT_L(0); PG8_BAR; PG8_MMA(0, 0, At, B0); PG8_MMA(0, 1, At, B1); PG8_BAR; PG8_SCHED;
            PG8_LDA(At, 1, 1); PG8_STAGE(PG8_SB(1, 0), b3, voffB); PG8_STAGE(PG8_SB(1, 1), b3 + hstep, voffB); PG8_STAGE(PG8_SA(1, 0), a3, va0);
            PG8_WAIT_V(8); PG8_WAIT_L(0); PG8_BAR; PG8_MMA(1, 0, At, B0); PG8_MMA(1, 1, At, B1); PG8_BAR; PG8_SCHED;
            } else {
            PG8_LDB(B0, 0, 0); PG8_SCHED; PG8_LDA(At, 0, 0); PG8_STAGE(PG8_SA(1, 1), a1 + hstep, voffA);
            PG8_WAIT_L(8); PG8_BAR; PG8_WAIT_L(0); PG8_MMA(0, 0, At, B0); PG8_BAR; PG8_SCHED;
            PG8_LDB(B1, 0, 1); PG8_STAGE(PG8_SB(0, 0), b2, voffB);
            PG8_BAR; PG8_WAIT_L(0); PG8_MMA(0, 1, At, B1); PG8_BAR;
            PG8_LDA(At, 0, 1); PG8_STAGE(PG8_SA(0, 0), a2, voffA);
            PG8_BAR; PG8_WAIT_L(0); PG8_MMA(1, 0, At, B0); PG8_BAR; PG8_SCHED;
            PG8_STAGE(PG8_SB(0, 1), b2 + hstep, voffB);
            PG8_WAIT_V(6); PG8_BAR; PG8_MMA(1, 1, At, B1); PG8_BAR;
            PG8_LDB(B0, 1, 0); PG8_SCHED; PG8_LDA(At, 1, 0); PG8_STAGE(PG8_SA(0, 1), a2 + hstep, voffA);
            PG8_WAIT_L(8); PG8_BAR; PG8_WAIT_L(0); PG8_MMA(0, 0, At, B0); PG8_BAR; PG8_SCHED;
            PG8_LDB(B1, 1, 1); PG8_STAGE(PG8_SB(1, 0), b3, voffB);
            PG8_BAR; PG8_WAIT_L(0); PG8_MMA(0, 1, At, B1); PG8_BAR;
            PG8_LDA(At, 1, 1); PG8_STAGE(PG8_SA(1, 0), a3, voffA);
            PG8_BAR; PG8_WAIT_L(0); PG8_MMA(1, 0, At, B0); PG8_BAR; PG8_SCHED;
            PG8_STAGE(PG8_SB(1, 1), b3 + hstep, voffB);
            PG8_WAIT_V(6); PG8_BAR; PG8_MMA(1, 1, At, B1); PG8_BAR;
            }
        }
        if constexpr (ALIGN_EPI) { if (wr == 0) PG8_BAR; }
        if constexpr (!Epi::AFTER_DRAIN) { E(acc, cur, wr, wc, fr, fq); S.done(cur); }
        if (!has_next) break;
#pragma unroll
        for (int a = 0; a < 2; ++a)
#pragma unroll
            for (int b = 0; b < 2; ++b)
#pragma unroll
                for (int m = 0; m < 4; ++m)
#pragma unroll
                    for (int n = 0; n < 2; ++n) acc[a][b][m][n] = (f32x4){0.f, 0.f, 0.f, 0.f};
        cur = nxt; cA = nA; cB = nB; ++ui;
        if constexpr (ALIGN_EPI) { if (wr == 1) PG8_BAR; }
    }
    PG8_WAIT_V(0);
    if constexpr (!ALIGN_EPI) { if (wr == 0) PG8_BAR; }
    PG8_BAR;
    if constexpr (Epi::AFTER_DRAIN) { E.fused(acc, cur, wr, wc, fr, fq, lds, wid, lane); S.done(cur); }
#undef PG8_VOFF
#undef PG8_SA
#undef PG8_SB
#undef PG8_STAGE
#undef PG8_LDA
#undef PG8_LDB
#undef PG8_MMA
#undef PG8_CAT
#undef PG8_WAIT_V
#undef PG8_WAIT_L
#undef PG8_BAR
#undef PG8_SCHED
}
}
namespace attn_body {
using bf16=unsigned short;
using bf16x8=__attribute__((ext_vector_type(8)))short;
using s16x4=__attribute__((ext_vector_type(4)))short;
using f32x16=__attribute__((ext_vector_type(16)))float;
using u32x4=__attribute__((ext_vector_type(4)))unsigned;
constexpr int BATCH=2,NHEAD=16,SEQ=8192,D=64,DM=NHEAD*D;
constexpr int NW=8,QBLK=32,QB=QBLK*NW,KVBLK=64,NQB=SEQ/QB;
constexpr int ATTN_PITCH=DM, ATTN_UNIT_ROWS=QB;
__device__ __forceinline__ int crow(int r,int hi){return (r&3)+8*(r>>2)+4*hi;}
#define SBAR() __builtin_amdgcn_sched_barrier(0)
__device__ __forceinline__ void cmask(f32x16&p0,f32x16&p1,int jb,int qrel,int hi){
  const float NEG=-INFINITY; int kb=64*jb+4*hi;
  #pragma unroll
  for(int r=0;r<16;++r){int kv=kb+(r&3)+8*(r>>2); if(kv>qrel)p0[r]=NEG; if(kv+32>qrel)p1[r]=NEG;}
}

constexpr int NSLOT=3, SLOTB=8192;
constexpr int VSLOTB=16384;
constexpr int LDS_K=0, LDS_V=NSLOT*SLOTB, LDS_WS=LDS_V+NSLOT*VSLOTB, LDS_OST=LDS_WS+NW*64*4, LDS_BYTES=LDS_OST+NW*8192;
constexpr float C2=0.125f*1.4426950408889634f;
__device__ __forceinline__ void glds16(const void*gsrc,unsigned lds_dst){unsigned keep;
  asm volatile("s_mov_b32 %0, m0\n\ts_mov_b32 m0, %2\n\ts_nop 0\n\tglobal_load_lds_dwordx4 %1, off\n\ts_mov_b32 m0, %0":"=&s"(keep):"v"(gsrc),"s"(lds_dst):"memory");}
__device__ __forceinline__ float max3f(float a,float b,float c){float r;asm("v_max3_f32 %0, %1, %2, %3":"=v"(r):"v"(a),"v"(b),"v"(c));return r;}
__device__ __forceinline__ float max2f(float a,float b){float r;asm("v_max_f32_e32 %0, %1, %2":"=v"(r):"v"(a),"v"(b));return r;}
__device__ __forceinline__ float fadd_s(float a,float b){float r;asm("v_add_f32_e32 %0, %1, %2":"=v"(r):"v"(a),"v"(b));return r;}
__device__ __forceinline__ float fsub_s(float a,float b){float r;asm("v_sub_f32_e32 %0, %1, %2":"=v"(r):"v"(a),"v"(b));return r;}
typedef float f32x2_t __attribute__((ext_vector_type(2))); typedef __bf16 bf16x2_t __attribute__((ext_vector_type(2)));
__device__ __forceinline__ unsigned cvtpk_s(float lo,float hi){f32x2_t v={lo,hi};bf16x2_t b=__builtin_convertvector(v,bf16x2_t);return __builtin_bit_cast(unsigned,b);}
#define WAIT_BAR(N) asm volatile("s_waitcnt vmcnt(" #N ") lgkmcnt(0)\n\ts_barrier":::"memory")

__device__ __forceinline__ void qkt(f32x16&p0,f32x16&p1,const char*Kslot,const bf16x8*qr,const f32x16&negm,int r32,int hi){
  const char*kb=Kslot+hi*1024+r32*16;
  #pragma unroll
  for(int d0=0;d0<4;++d0){
    const bf16x8 b0=*reinterpret_cast<const bf16x8*>(kb+d0*2048);
    const bf16x8 b1=*reinterpret_cast<const bf16x8*>(kb+d0*2048+512);
    if(d0==0){p0=__builtin_amdgcn_mfma_f32_32x32x16_bf16(b0,qr[0],negm,0,0,0);p1=__builtin_amdgcn_mfma_f32_32x32x16_bf16(b1,qr[0],negm,0,0,0);}
    else{p0=__builtin_amdgcn_mfma_f32_32x32x16_bf16(b0,qr[d0],p0,0,0,0);p1=__builtin_amdgcn_mfma_f32_32x32x16_bf16(b1,qr[d0],p1,0,0,0);}}
}
typedef __attribute__((address_space(3))) const char* lds_cptr;
typedef short v4i16_t __attribute__((ext_vector_type(4)));
__device__ __forceinline__ void kload8(bf16x8*kf,lds_cptr kp){
  kf[0]=*(const __attribute__((address_space(3))) bf16x8*)(kp);      kf[1]=*(const __attribute__((address_space(3))) bf16x8*)(kp+512);
  kf[2]=*(const __attribute__((address_space(3))) bf16x8*)(kp+2048); kf[3]=*(const __attribute__((address_space(3))) bf16x8*)(kp+2560);
  kf[4]=*(const __attribute__((address_space(3))) bf16x8*)(kp+4096); kf[5]=*(const __attribute__((address_space(3))) bf16x8*)(kp+4608);
  kf[6]=*(const __attribute__((address_space(3))) bf16x8*)(kp+6144); kf[7]=*(const __attribute__((address_space(3))) bf16x8*)(kp+6656);
}
__device__ __forceinline__ void kload2(bf16x8*kf,lds_cptr kp,int j){ kf[2*j]=*(const __attribute__((address_space(3))) bf16x8*)(kp+j*2048); kf[2*j+1]=*(const __attribute__((address_space(3))) bf16x8*)(kp+j*2048+512); }
__device__ __forceinline__ s16x4 vtr(lds_cptr p){ return __builtin_bit_cast(s16x4,__builtin_amdgcn_ds_read_tr16_b64_v4i16((__attribute__((address_space(3))) v4i16_t*)p)); }
__device__ __forceinline__ float rowmax(const f32x16&p0,const f32x16&p1){
  float a=max3f(p0[0],p0[1],p1[0]),b=max3f(p0[2],p0[3],p1[1]);a=max3f(a,p1[2],p1[3]);
  #pragma unroll
  for(int r=4;r<16;r+=4){a=max3f(a,p0[r],p0[r+1]);b=max3f(b,p0[r+2],p0[r+3]);a=max3f(a,p1[r],p1[r+1]);b=max3f(b,p1[r+2],p1[r+3]);}
  const float m=max2f(a,b);
  auto rr=__builtin_amdgcn_permlane32_swap(__float_as_uint(m),__float_as_uint(m),false,false);
  return max2f(__uint_as_float(rr[0]),__uint_as_float(rr[1]));
}
__device__ __forceinline__ void pv(f32x16*o,int vb,bf16x8 pa0,bf16x8 pa1,bf16x8 pa2,bf16x8 pa3){
  #pragma unroll
  for(int d0=0;d0<4;++d0){s16x4 lo[4],hi[4];
    #pragma unroll
    for(int ks=0;ks<4;++ks){
      asm volatile("ds_read_b64_tr_b16 %0,%1 offset:%c2":"=&v"(lo[ks]):"v"(vb),"i"(d0*4096+ks*1024):"memory");
      asm volatile("ds_read_b64_tr_b16 %0,%1 offset:%c2":"=&v"(hi[ks]):"v"(vb),"i"(d0*4096+ks*1024+512):"memory");}
    asm volatile("s_waitcnt lgkmcnt(0)":::"memory");SBAR();
    #define PK(k) (bf16x8){lo[k][0],lo[k][1],lo[k][2],lo[k][3],hi[k][0],hi[k][1],hi[k][2],hi[k][3]}
    o[d0]=__builtin_amdgcn_mfma_f32_32x32x16_bf16(pa0,PK(0),o[d0],0,0,0);
    o[d0]=__builtin_amdgcn_mfma_f32_32x32x16_bf16(pa1,PK(1),o[d0],0,0,0);
    o[d0]=__builtin_amdgcn_mfma_f32_32x32x16_bf16(pa2,PK(2),o[d0],0,0,0);
    o[d0]=__builtin_amdgcn_mfma_f32_32x32x16_bf16(pa3,PK(3),o[d0],0,0,0);
    #undef PK
  }
}

#ifndef ATTN_STORE16
#define ATTN_STORE16(p,v) (*(u32x4*)(p)=(v))
#endif
template<int THRL> __device__ __forceinline__ void attn_unit(int b,int h,int qb,int vcol,const bf16*Q,const bf16*__restrict__ K,const bf16*__restrict__ V,bf16*Ob,int opitch,char*shm){
  int tid_=threadIdx.x; asm volatile("":"+v"(tid_)); const int tid=tid_,lane=tid&63,r32=lane&31,hi=lane>>5; const int wid=__builtin_amdgcn_readfirstlane(tid>>6);
  const long rowbase=(long)b*SEQ; const int q0=qb*QB;
  const bf16*Qw=Q+(rowbase+q0+wid*QBLK)*DM+h*D;
  const bf16*Kh=K+rowbase*DM+h*D,*Vh=V+rowbase*DM+vcol;
  const unsigned lds0=(unsigned)(uintptr_t)shm;
  float*wsf=(float*)(shm+LDS_WS)+wid*64;
  const bf16*ksrc=Kh+(long)lane*DM+wid*8;
  const bf16*vsrc=Vh+(long)(16*(wid&3)+(lane>>2))*DM+(wid>>2)*32+(lane&3)*8;
  const unsigned kdst=lds0+LDS_K+wid*1024, vdst=lds0+LDS_V+wid*1024;
  #define DMA_K(t,slot) glds16(ksrc+(long)(t)*KVBLK*DM,(unsigned)__builtin_amdgcn_readfirstlane(kdst+(slot)))
  #define DMA_V(t,slot) do{ glds16(vsrc+(long)(t)*KVBLK*DM,(unsigned)__builtin_amdgcn_readfirstlane(vdst+2*(slot))); glds16(vsrc+(long)(t)*KVBLK*DM+64,(unsigned)__builtin_amdgcn_readfirstlane(vdst+2*(slot)+8192)); }while(0)
  const int vb0=(int)(lds0+LDS_V)+((lane>>4)&1)*32+(lane&3)*8+(4*hi+((lane&15)>>2))*64;
  const char*Kbase=shm+LDS_K; bf16x8 kf[8];
  const lds_cptr shm3=(lds_cptr)shm; const lds_cptr kp0=shm3+LDS_K+hi*1024+r32*16; const lds_cptr vp0=shm3+LDS_V+((lane>>4)&1)*32+(lane&3)*8+(4*hi+((lane&15)>>2))*64;
  const int NT=(q0+QB)/KVBLK;
  DMA_K(0,0);DMA_V(0,0);DMA_K(1,SLOTB);
  bf16x8 qr[4];
  #pragma unroll
  for(int d0=0;d0<4;++d0)qr[d0]=*reinterpret_cast<const bf16x8*>(&Qw[(long)r32*DM+d0*16+hi*8]);
  const lds_cptr qp0=shm3+LDS_OST+wid*8192+lane*16;
  #pragma unroll
  for(int d0=0;d0<4;++d0)*(__attribute__((address_space(3))) bf16x8*)(qp0+d0*1024)=qr[d0];
  #define QF(i) (*(const __attribute__((address_space(3))) bf16x8*)(qp0+(i)*1024))
  float mhat=0.f,l_reg=0.f;f32x16 o[4];o[0]=f32x16{};o[1]=f32x16{};o[2]=f32x16{};o[3]=f32x16{};const f32x16 zc=f32x16{};
  const int qrel=wid*QBLK+r32;
  #define CMASK(P0,P1,t) do{int jb_=(t)-(NT-4); if(jb_>=0)cmask(P0,P1,jb_,qrel,hi);}while(0)
  bool resc=false;
  #define START(P0,P1) do{ const float rm=rowmax(P0,P1); resc=false; \
    { const float dl=(rm>(float)THRL)?rm:0.f; mhat=fadd_s(mhat,dl); \
      _Pragma("unroll") for(int r=0;r<16;++r){P0[r]=fsub_s(P0[r],dl);P1[r]=fsub_s(P1[r],dl);} \
      } \
    _Pragma("unroll") for(int r=0;r<16;++r)P0[r]=__builtin_amdgcn_exp2f(P0[r]); }while(0)
  #define RESC() do{ if(resc){ asm volatile("s_waitcnt lgkmcnt(0)":::"memory"); \
      _Pragma("unroll") for(int d_=0;d_<4;++d_) _Pragma("unroll") for(int r=0;r<16;++r)o[d_][r]*=wsf[crow(r,hi)]; } }while(0)
  f32x16 pA0,pA1,pB0,pB1;
  int sl_prev=0,sl_cur=0,sl_next=SLOTB;
  #define ROT() do{sl_prev=sl_cur;sl_cur=sl_next;sl_next=(sl_next==(NSLOT-1)*SLOTB)?0:sl_next+SLOTB;}while(0)
  DMA_K(2,2*SLOTB);
  WAIT_BAR(4);
  qkt(pA0,pA1,Kbase,qr,zc,r32,hi);asm volatile("s_nop 15\n\ts_nop 7":"+v"(pA0),"+v"(pA1));CMASK(pA0,pA1,0);
  START(pA0,pA1);
  _Pragma("unroll") for(int r=0;r<16;++r)pA1[r]=__builtin_amdgcn_exp2f(pA1[r]);
  WAIT_BAR(0);
  DMA_K(3,0);DMA_V(1,SLOTB);
  ROT();
  kload8(kf,kp0+sl_cur);
  WAIT_BAR(3);
  s16x4 vlo[8],vhi[8]; u32x4 pw0,pw1,pw2,pw3;
  #define PKW(P,B) cvtpk_s(P[B],P[B+1])
  #define PAF(k) __builtin_bit_cast(bf16x8,pw##k)
  #define VFR(i) (bf16x8){vlo[i][0],vlo[i][1],vlo[i][2],vlo[i][3],vhi[i][0],vhi[i][1],vhi[i][2],vhi[i][3]}
  #define PIN(x) asm volatile("":"+v"(x))
  #define MX3(a,b,c) __builtin_fmaxf(__builtin_fmaxf((a),(b)),(c))
  #define GAPA(MF,A0,A1,A2,A3,W0,W1,PW) do{ MF; sacc+=A0; sacc+=A1; sacc+=A2; sacc+=A3; PIN(sacc); W0; W1; PIN(PW); SBAR(); }while(0)
  #define EX(v) __builtin_amdgcn_exp2f(v)
  #define GAPB(MF,X,B) do{ MF; X[B]=EX(X[B]); X[B+1]=EX(X[B+1]); X[B+2]=EX(X[B+2]); X[B+3]=EX(X[B+3]); PIN(X); SBAR(); }while(0)
  #define VRD(i) do{ vlo[i]=vtr(vp_+(((i)>>2)*4096+((i)&3)*1024)); vhi[i]=vtr(vp_+(((i)>>2)*4096+((i)&3)*1024+512)); }while(0)
  #define VRD2(i) do{ vlo[i]=vtr(vp_+(8192+((i)>>2)*4096+((i)&3)*1024)); vhi[i]=vtr(vp_+(8192+((i)>>2)*4096+((i)&3)*1024+512)); SBAR(); }while(0)
  #define GAPB2(MF,X,B) do{ MF; X[B]=EX(X[B]); X[B+1]=EX(X[B+1]); PIN(X); SBAR(); }while(0)
  #define KRD(G,j) do{ if(G){ kload2(kf,kp0+sl_next,j); SBAR(); } }while(0)
  #define STEP(C0,C1,P0,P1,t,GK,GV,GL) do{ SBAR(); \
    const lds_cptr vp_=vp0+2*sl_prev; \
    VRD(0); bf16x8 qe_=QF(0); SBAR(); float sacc=(P0[0]+P0[1]); \
    GAPA(C0=__builtin_amdgcn_mfma_f32_32x32x16_bf16(kf[0],qe_,zc,0,0,0), P0[2],P0[3],P0[4],P0[5],     pw0[0]=PKW(P0,0), pw0[1]=PKW(P0,2), pw0); \
    bf16x8 qo_=QF(1); SBAR(); GAPA(C1=__builtin_amdgcn_mfma_f32_32x32x16_bf16(kf[1],qe_,zc,0,0,0), P0[6],P0[7],P0[8],P0[9],     pw0[2]=PKW(P0,4), pw0[3]=PKW(P0,6), pw0); \
    VRD(1); SBAR(); GAPA(C0=__builtin_amdgcn_mfma_f32_32x32x16_bf16(kf[2],qo_,C0,0,0,0),   P0[10],P0[11],P0[12],P0[13], pw1[0]=PKW(P0,8), pw1[1]=PKW(P0,10), pw1); \
    qe_=QF(2); SBAR(); GAPA(C1=__builtin_amdgcn_mfma_f32_32x32x16_bf16(kf[3],qo_,C1,0,0,0),   P0[14],P0[15],P1[0],P1[1],   pw1[2]=PKW(P0,12),pw1[3]=PKW(P0,14), pw1); \
    VRD(2); SBAR(); GAPA(C0=__builtin_amdgcn_mfma_f32_32x32x16_bf16(kf[4],qe_,C0,0,0,0),   P1[2],P1[3],P1[4],P1[5],     pw2[0]=PKW(P1,0), pw2[1]=PKW(P1,2), pw2); \
    qo_=QF(3); SBAR(); GAPA(C1=__builtin_amdgcn_mfma_f32_32x32x16_bf16(kf[5],qe_,C1,0,0,0),   P1[6],P1[7],P1[8],P1[9],     pw2[2]=PKW(P1,4), pw2[3]=PKW(P1,6), pw2); \
    VRD(3); SBAR(); GAPA(C0=__builtin_amdgcn_mfma_f32_32x32x16_bf16(kf[6],qo_,C0,0,0,0),   P1[10],P1[11],P1[12],P1[13], pw3[0]=PKW(P1,8), pw3[1]=PKW(P1,10), pw3); \
    VRD(4); SBAR(); GAPA(C1=__builtin_amdgcn_mfma_f32_32x32x16_bf16(kf[7],qo_,C1,0,0,0),   P1[14],P1[15],0.f,0.f,       pw3[2]=PKW(P1,12),pw3[3]=PKW(P1,14), pw3); \
    l_reg+=sacc; \
    if(__any(mhat!=0.f)){ _Pragma("unroll") for(int r=0;r<16;++r){C0[r]-=mhat;C1[r]-=mhat;} } \
    if(GK){DMA_K((t)+3,sl_cur);} if(GV){DMA_V((t)+1,sl_next);} \
    CMASK(C0,C1,t); \
    { float a=MX3(C0[0],C0[1],C1[0]),b=MX3(C0[2],C0[3],C1[1]); a=MX3(a,C1[2],C1[3]); \
      _Pragma("unroll") for(int r=4;r<16;r+=4){a=MX3(a,C0[r],C0[r+1]);b=MX3(b,C0[r+2],C0[r+3]);a=MX3(a,C1[r],C1[r+1]);b=MX3(b,C1[r+2],C1[r+3]);} \
      float rm=__builtin_fmaxf(a,b); { auto rr=__builtin_amdgcn_permlane32_swap(__float_as_uint(rm),__float_as_uint(rm),false,false); rm=__builtin_fmaxf(__uint_as_float(rr[0]),__uint_as_float(rr[1])); } \
      resc=false; \
      if(__builtin_expect(__any(rm>(float)THRL),0)){ const float dl=__builtin_fmaxf(rm,0.f); mhat+=dl; \
        _Pragma("unroll") for(int r=0;r<16;++r){C0[r]-=dl;C1[r]-=dl;} \
        const float f=__builtin_amdgcn_exp2f(-dl); l_reg*=f; if(hi==0)wsf[r32]=f; resc=true; } } \
    SBAR(); \
    GAPB2(o[0]=__builtin_amdgcn_mfma_f32_32x32x16_bf16(PAF(0),VFR(0),o[0],0,0,0), C0,0); VRD(5); SBAR(); VRD2(0); \
    GAPB2(o[1]=__builtin_amdgcn_mfma_f32_32x32x16_bf16(PAF(0),VFR(4),o[1],0,0,0), C0,2); VRD2(4); \
    KRD(GL,0); GAPB2(o[0]=__builtin_amdgcn_mfma_f32_32x32x16_bf16(PAF(1),VFR(1),o[0],0,0,0), C0,4); VRD(6); SBAR(); VRD2(1); \
    KRD(GL,1); GAPB2(o[1]=__builtin_amdgcn_mfma_f32_32x32x16_bf16(PAF(1),VFR(5),o[1],0,0,0), C0,6); VRD2(5); \
    KRD(GL,2); GAPB2(o[0]=__builtin_amdgcn_mfma_f32_32x32x16_bf16(PAF(2),VFR(2),o[0],0,0,0), C0,8); VRD(7); SBAR(); VRD2(2); \
    KRD(GL,3); GAPB2(o[1]=__builtin_amdgcn_mfma_f32_32x32x16_bf16(PAF(2),VFR(6),o[1],0,0,0), C0,10); VRD2(6); \
    GAPB2(o[0]=__builtin_amdgcn_mfma_f32_32x32x16_bf16(PAF(3),VFR(3),o[0],0,0,0), C0,12); VRD2(3); \
    GAPB2(o[1]=__builtin_amdgcn_mfma_f32_32x32x16_bf16(PAF(3),VFR(7),o[1],0,0,0), C0,14); VRD2(7); \
    GAPB2(o[2]=__builtin_amdgcn_mfma_f32_32x32x16_bf16(PAF(0),VFR(0),o[2],0,0,0), C1,0); \
    GAPB2(o[3]=__builtin_amdgcn_mfma_f32_32x32x16_bf16(PAF(0),VFR(4),o[3],0,0,0), C1,2); \
    GAPB2(o[2]=__builtin_amdgcn_mfma_f32_32x32x16_bf16(PAF(1),VFR(1),o[2],0,0,0), C1,4); \
    GAPB2(o[3]=__builtin_amdgcn_mfma_f32_32x32x16_bf16(PAF(1),VFR(5),o[3],0,0,0), C1,6); \
    GAPB2(o[2]=__builtin_amdgcn_mfma_f32_32x32x16_bf16(PAF(2),VFR(2),o[2],0,0,0), C1,8); \
    GAPB2(o[3]=__builtin_amdgcn_mfma_f32_32x32x16_bf16(PAF(2),VFR(6),o[3],0,0,0), C1,10); \
    GAPB2(o[2]=__builtin_amdgcn_mfma_f32_32x32x16_bf16(PAF(3),VFR(3),o[2],0,0,0), C1,12); \
    GAPB2(o[3]=__builtin_amdgcn_mfma_f32_32x32x16_bf16(PAF(3),VFR(7),o[3],0,0,0), C1,14); \
    }while(0)
  int t=1;
  #undef CMASK
  #define CMASK(P0,P1,t) do{}while(0)
  for(;t+5<NT;t+=2){
    STEP(pB0,pB1,pA0,pA1,t,true,true,true);     WAIT_BAR(3); RESC(); ROT();
    STEP(pA0,pA1,pB0,pB1,t+1,true,true,true);   WAIT_BAR(3); RESC(); ROT();
  }
  #undef CMASK
  #define CMASK(P0,P1,t) do{int jb_=(t)-(NT-4); if(jb_>=0)cmask(P0,P1,jb_,qrel,hi);}while(0)
  #define ENDW(tt) do{ if((tt)+3<NT){WAIT_BAR(3);} else if((tt)+2<NT){WAIT_BAR(2);} else {WAIT_BAR(0);} }while(0)
  for(;t+1<NT;t+=2){
    STEP(pB0,pB1,pA0,pA1,t,(t+3<NT),(t+1<NT),(t+1<NT));       ENDW(t);   RESC(); ROT();
    STEP(pA0,pA1,pB0,pB1,t+1,(t+4<NT),(t+2<NT),(t+2<NT));     ENDW(t+1); RESC(); ROT();
  }
  STEP(pB0,pB1,pA0,pA1,NT-1,false,false,false); RESC();
  { float sacc=pB0[0]+pB0[1]; _Pragma("unroll") for(int r=2;r<16;++r)sacc+=pB0[r]; _Pragma("unroll") for(int r=0;r<16;++r)sacc+=pB1[r]; l_reg+=sacc;
    pw0=(u32x4){PKW(pB0,0),PKW(pB0,2),PKW(pB0,4),PKW(pB0,6)};pw1=(u32x4){PKW(pB0,8),PKW(pB0,10),PKW(pB0,12),PKW(pB0,14)};pw2=(u32x4){PKW(pB1,0),PKW(pB1,2),PKW(pB1,4),PKW(pB1,6)};pw3=(u32x4){PKW(pB1,8),PKW(pB1,10),PKW(pB1,12),PKW(pB1,14)};
    SBAR(); pv(o,vb0+2*sl_cur,PAF(0),PAF(1),PAF(2),PAF(3)); }
  #undef PKW
  #undef PAF
  #undef VFR
  #undef PIN
  #undef MX3
  #undef GAPA
  #undef GAPB
  #undef EX
  #undef VRD
  #undef VRD2
  #undef QF
  #undef GAPB2
  #undef KRD
  #undef STEP
  #undef ENDW
  {auto rr=__builtin_amdgcn_permlane32_swap(__float_as_uint(l_reg),__float_as_uint(l_reg),false,false);l_reg=__uint_as_float(rr[0])+__uint_as_float(rr[1]);}
  if(hi==0)wsf[32+r32]=l_reg;asm volatile("s_waitcnt lgkmcnt(0)":::"memory");
  float rli[16];
  #pragma unroll
  for(int r=0;r<16;++r)rli[r]=__builtin_amdgcn_rcpf(wsf[32+crow(r,hi)]);
  bf16*Ow=Ob+(long)(wid*QBLK)*opitch;
  { bf16*stg=(bf16*)(shm+LDS_OST)+wid*4096;
    #pragma unroll
    for(int r=0;r<16;++r){const int orow=crow(r,hi);
      #pragma unroll
      for(int d0=0;d0<4;++d0)stg[orow*128+d0*32+r32]=(bf16)f2bf(o[d0][r]*rli[r]);}
    asm volatile("s_waitcnt lgkmcnt(0)":::"memory");
    #pragma unroll
    for(int i=0;i<8;++i){const int row=i*4+(lane>>4),ch=lane&15; const u32x4 v=*(const u32x4*)(stg+row*128+ch*8); ATTN_STORE16(Ow+(long)row*opitch+ch*8,v);} }
  asm volatile("s_waitcnt lgkmcnt(0)\n\ts_barrier":::"memory");
  #undef DMA_K
  #undef DMA_V
  #undef CMASK
  #undef START
  #undef RESC
  #undef ROT
}
constexpr int ATTN_LDS_BYTES=LDS_BYTES;
#undef SBAR
#undef WAIT_BAR
}
namespace mk {
using pg8::Unit; using pg8::BM; using pg8::HALF;
typedef __bf16 bf16x2_t __attribute__((ext_vector_type(2)));
__device__ __forceinline__ unsigned cvtpk(float lo, float hi) { const f32x2 v = {lo, hi}; const bf16x2_t b = __builtin_convertvector(v, bf16x2_t); return __builtin_bit_cast(unsigned, b); }
__device__ __forceinline__ v4u pack8(f32x4 a, f32x4 b) { v4u w; w.x = cvtpk(a[0], a[1]); w.y = cvtpk(a[2], a[3]); w.z = cvtpk(b[0], b[1]); w.w = cvtpk(b[2], b[3]); return w; }
__device__ __forceinline__ f32x4 up_lo(v4u w) { return (f32x4){__builtin_bit_cast(float, w.x << 16), __builtin_bit_cast(float, w.x & 0xffff0000u), __builtin_bit_cast(float, w.y << 16), __builtin_bit_cast(float, w.y & 0xffff0000u)}; }
__device__ __forceinline__ f32x4 up_hi(v4u w) { return (f32x4){__builtin_bit_cast(float, w.z << 16), __builtin_bit_cast(float, w.z & 0xffff0000u), __builtin_bit_cast(float, w.w << 16), __builtin_bit_cast(float, w.w & 0xffff0000u)}; }
__device__ __forceinline__ float fsig(float x) { return __builtin_amdgcn_rcpf(1.f + __builtin_amdgcn_exp2f(-1.4426950408889634f * x)); }
__device__ __forceinline__ f32x4 sig4(f32x4 v) { return (f32x4){fsig(v[0]), fsig(v[1]), fsig(v[2]), fsig(v[3])}; }
__device__ __forceinline__ f32x4 silu4(f32x4 v) { return v * sig4(v); }

struct TrItem { const float* W; size_t ldw; int k0, c0; bf16* WT; size_t ldt; int drow0; };
__device__ __forceinline__ void transpose_load(const TrItem& t, f32x4 (&v)[8], int lane) {
#pragma unroll
    for (int i = 0; i < 8; ++i) v[i] = __builtin_nontemporal_load((const f32x4*)(t.W + (size_t)(t.k0 + (lane >> 3) + 8 * i) * t.ldw + t.c0 + 4 * (lane & 7)));
}
__device__ __forceinline__ void transpose_finish(const TrItem& t, const f32x4 (&v)[8], LAS float* scr, int lane) {
#pragma unroll
    for (int i = 0; i < 8; ++i) { LAS float* d = scr + ((lane >> 3) + 8 * i) * 33 + 4 * (lane & 7); d[0] = v[i][0]; d[1] = v[i][1]; d[2] = v[i][2]; d[3] = v[i][3]; }
    asm volatile("s_waitcnt lgkmcnt(0)" ::: "memory");
    const int c = lane & 7;
#pragma unroll
    for (int j = 0; j < 4; ++j) { const int n = (lane >> 3) + 8 * j; const LAS float* s = scr + (8 * c) * 33 + n;
        v4u o; o.x = pk2(s[0 * 33], s[1 * 33]); o.y = pk2(s[2 * 33], s[3 * 33]); o.z = pk2(s[4 * 33], s[5 * 33]); o.w = pk2(s[6 * 33], s[7 * 33]);
        *(GAS v4u*)(t.WT + (size_t)(t.drow0 + n) * t.ldt + t.k0 + 8 * c) = o; }
    asm volatile("s_waitcnt lgkmcnt(0)" ::: "memory");
}
__device__ __forceinline__ unsigned pk4_fp8(float a, float b, float c, float d) { int w = __builtin_amdgcn_cvt_pk_fp8_f32(a, b, 0, false); w = __builtin_amdgcn_cvt_pk_fp8_f32(c, d, w, true); return (unsigned)w; }
__device__ __forceinline__ float clamp8(float x) { return __builtin_amdgcn_fmed3f(x, -448.f, 448.f); }
__device__ __forceinline__ void transpose_finish8(const TrItem& t, const f32x4 (&v)[8], LAS float* scr, int lane, float scale) {
#pragma unroll
    for (int i = 0; i < 8; ++i) { LAS float* d = scr + ((lane >> 3) + 8 * i) * 33 + 4 * (lane & 7); d[0] = v[i][0]; d[1] = v[i][1]; d[2] = v[i][2]; d[3] = v[i][3]; }
    asm volatile("s_waitcnt lgkmcnt(0)" ::: "memory");
    const int n = lane & 31, kh = lane >> 5; const LAS float* s = scr + (32 * kh) * 33 + n;
    unsigned w[8];
#pragma unroll
    for (int j = 0; j < 8; ++j) w[j] = pk4_fp8(s[(4 * j) * 33] * scale, s[(4 * j + 1) * 33] * scale, s[(4 * j + 2) * 33] * scale, s[(4 * j + 3) * 33] * scale);
    unsigned char* o = (unsigned char*)t.WT + (size_t)(t.drow0 + n) * t.ldt + t.k0 + 32 * kh;
    *(GAS v4u*)o = (v4u){w[0], w[1], w[2], w[3]}; *(GAS v4u*)(o + 16) = (v4u){w[4], w[5], w[6], w[7]};
    asm volatile("s_waitcnt lgkmcnt(0)" ::: "memory");
}
__device__ __forceinline__ void transpose_item(const float* W, size_t ldw, int k0, int c0, bf16* WT, size_t ldt, int drow0, LAS float* scr, int lane) {
    const TrItem t{W, ldw, k0, c0, WT, ldt, drow0}; f32x4 v[8]; transpose_load(t, v, lane); transpose_finish(t, v, scr, lane);
}
__device__ __forceinline__ int win_drow(int c0) {
    if (c0 >= C_V) return c0;
    const int seg = c0 < C_K ? 0 : C_K, cc = c0 - seg, hm = cc >> 6, bj = (cc & 63) >> 5;
    return seg + (hm >> 2) * 256 + bj * 128 + (hm & 3) * 32;
}
__device__ __forceinline__ void conv_mixer_weights(KP p, LAS unsigned char* lds) {
    const int lane = threadIdx.x & 63, wv = threadIdx.x >> 6;
    LAS float* scr = (LAS float*)(lds + wv * 16384);
    const int gw = blockIdx.x * NWAVE + wv, ngw = gridDim.x * NWAVE;
    constexpr int I_IN = 16 * 320, I_A = 16 * 32, I_B = 32 * 32, I_O = 16 * 32;
    bf16* WTIN = (bf16*)(p->ws + WS_WTIN); bf16* WTA = (bf16*)(p->ws + WS_WTA); bf16* WTB = (bf16*)(p->ws + WS_WTB); bf16* WTO = (bf16*)(p->ws + WS_WTOUT);
    for (int it = gw; it < I_IN + I_A + I_B + I_O; it += ngw) {
        int r = it;
        if (r < I_IN) { const int kb = r / 320, nb = r % 320;
            if (nb * 32 >= C_Z) { const TrItem t{p->w_in, (size_t)INW, kb * 64, nb * 32, (bf16*)(p->ws + WS_WTIN8), (size_t)1024, nb * 32 - C_Z}; f32x4 v[8]; transpose_load(t, v, lane); transpose_finish8(t, v, scr, lane, WIN_SCALE); }
            else transpose_item(p->w_in, INW, kb * 64, nb * 32, WTIN, 1024, win_drow(nb * 32), scr, lane);
            continue; } r -= I_IN;
        if (r < I_A) { const int kb = r / 32, nb = r % 32; transpose_item(p->w_branch_a, 1024, kb * 64, nb * 32, WTA, 1024, nb * 32, scr, lane); continue; } r -= I_A;
        if (r < I_B) { const int kb = r / 32, nb = r % 32; transpose_item(p->w_branch_b, 1024, kb * 64, nb * 32, WTB, 2048, nb * 32, scr, lane); continue; } r -= I_B;
        { const int kb = r / 32, nb = r % 32; transpose_item(p->w_out, 1024, kb * 64, nb * 32, WTO, 1024, nb * 32, scr, lane); }
    }
}
struct EpiSsdCols {
    static constexpr bool PERM = true, AFTER_DRAIN = false;
    unsigned char* ws;
    __device__ __forceinline__ void operator()(const f32x4 (&acc)[2][2][4][2], const Unit& u, int wr, int wc, int fr, int fq) const {
        const int row0 = u.pm * BM + wr * 64 + fr; const bool isz = u.pn < 8;
        bf16* base = (bf16*)(ws + (isz ? WS_A : WS_B)); const int ldc = isz ? 2048 : 3072; const int col0 = (isz ? u.pn : u.pn - 8) * BM + wc * 32 + 8 * fq;
#pragma unroll
        for (int ai = 0; ai < 2; ++ai)
#pragma unroll
            for (int m = 0; m < 4; ++m) { bf16* rowp = base + (size_t)(row0 + ai * HALF + m * 16) * ldc + col0;
#pragma unroll
                for (int bj = 0; bj < 2; ++bj) { f32x4 v0 = acc[ai][bj][m][0] * (1.f / WIN_SCALE), v1 = acc[ai][bj][m][1] * (1.f / WIN_SCALE);
                    if (isz) { v0 = silu4(v0); v1 = silu4(v1); }
                    *(v4u*)(rowp + bj * HALF) = pack8(v0, v1); } }
    }
};
struct EpiAttCols {
    static constexpr bool PERM = true, AFTER_DRAIN = false;
    unsigned char* ws; const float* qg; const float* kg; const float* rope; float qscale;
    XcdBarrier bar; bool split; volatile LAS unsigned* pend;
    __device__ __forceinline__ void operator()(const f32x4 (&acc)[2][2][4][2], const Unit& u, int wr, int wc, int fr, int fq) const {
        const int row0 = u.pm * BM + wr * 64 + fr;
        if (split && pend[0] != 0u) { xcd_barrier_wait(bar); if (threadIdx.x == 0) pend[0] = 0u; }
        if (u.pn < 8) {
            const bool isq = u.pn < 4; bf16* base = (bf16*)(ws + (isq ? WS_Q : WS_K)); const float* g = isq ? qg : kg; const float sc = isq ? qscale : 1.f;
            const int hm = 4 * (u.pn & 3) + wc;
            const f32x4 g00 = *(const f32x4*)(g + 8 * fq), g01 = *(const f32x4*)(g + 8 * fq + 4), g10 = *(const f32x4*)(g + 32 + 8 * fq), g11 = *(const f32x4*)(g + 36 + 8 * fq);
            constexpr int W = 2;
            f32x4 rr[8][4];
#define AT_LOAD(i_) do { const f32x4* rp_ = (const f32x4*)(rope + ((size_t)(row0 + ((i_) >> 2) * HALF + ((i_) & 3) * 16) * 32 + 8 * fq) * 2); rr[i_][0] = rp_[0]; rr[i_][1] = rp_[1]; rr[i_][2] = rp_[2]; rr[i_][3] = rp_[3]; } while (0)
#pragma unroll
            for (int i = 0; i < W; ++i) AT_LOAD(i);
#pragma unroll
            for (int gi = 0; gi < 8; ++gi) { const int ai = gi >> 2, m = gi & 3; const int row = row0 + ai * HALF + m * 16;
                    if (gi + W < 8) AT_LOAD(gi + W);
                    f32x4 a00 = acc[ai][0][m][0], a01 = acc[ai][0][m][1], a10 = acc[ai][1][m][0], a11 = acc[ai][1][m][1];
                    const f32x4 q = a00 * a00 + a01 * a01 + a10 * a10 + a11 * a11;
                    float ss = (q[0] + q[1]) + (q[2] + q[3]);
                    ss += __shfl_xor(ss, 16); ss += __shfl_xor(ss, 32);
                    const float r = __builtin_amdgcn_rsqf(ss * (1.f / 64.f) + EPS);
                    a00 = a00 * r * g00; a01 = a01 * r * g01; a10 = a10 * r * g10; a11 = a11 * r * g11;
                    const f32x4 r0 = rr[gi][0], r1 = rr[gi][1], r2 = rr[gi][2], r3 = rr[gi][3];
                    const f32x4 c0 = {r0[0], r0[2], r1[0], r1[2]}, s0 = {r0[1], r0[3], r1[1], r1[3]}, c1 = {r2[0], r2[2], r3[0], r3[2]}, s1 = {r2[1], r2[3], r3[1], r3[3]};
                    const f32x4 o00 = (a00 * c0 - a10 * s0) * sc, o01 = (a01 * c1 - a11 * s1) * sc, o10 = (a10 * c0 + a00 * s0) * sc, o11 = (a11 * c1 + a01 * s1) * sc;
                    bf16* rowp = base + (size_t)row * 1024 + hm * 64 + 8 * fq;
                    *(v4u*)rowp = pack8(o00, o01); *(v4u*)(rowp + 32) = pack8(o10, o11); }
#undef AT_LOAD
        } else {
            const int seg = (u.pn - 8) >> 2; bf16* base = (bf16*)(ws + (seg == 0 ? WS_V : (seg == 1 ? WS_GA : WS_GB))); const int col0 = ((u.pn - 8) & 3) * BM + wc * 32 + 8 * fq;
#pragma unroll
            for (int ai = 0; ai < 2; ++ai)
#pragma unroll
                for (int m = 0; m < 4; ++m) { bf16* rowp = base + (size_t)(row0 + ai * HALF + m * 16) * 1024 + col0;
#pragma unroll
                    for (int bj = 0; bj < 2; ++bj) { f32x4 v0 = acc[ai][bj][m][0], v1 = acc[ai][bj][m][1];
                        if (seg != 0) { v0 = sig4(v0); v1 = sig4(v1); }
                        *(v4u*)(rowp + bj * HALF) = pack8(v0, v1); } }
        }
    }
};
struct EpiGateB {
    static constexpr bool PERM = true, AFTER_DRAIN = false;
    bf16* TMP; const bf16* GB; XcdBarrier bar; bool split; volatile LAS unsigned* pend;
    __device__ __forceinline__ void operator()(const f32x4 (&acc)[2][2][4][2], const Unit& u, int wr, int wc, int fr, int fq) const {
        const int row0 = u.pm * BM + wr * 64 + fr, col0 = u.pn * BM + wc * 32 + 8 * fq;
        if (split && pend[0] != 0u) { xcd_barrier_wait(bar); if (threadIdx.x == 0) pend[0] = 0u; }
        constexpr int W = 8;
        v4u gb[16];
#define MG_OFF(i_) ((size_t)(row0 + ((i_) >> 3) * HALF + (((i_) >> 1) & 3) * 16) * 1024 + col0 + ((i_) & 1) * HALF)
#pragma unroll
        for (int i = 0; i < W; ++i) gb[i] = __builtin_nontemporal_load((const v4u*)(GB + MG_OFF(i)));
#pragma unroll
        for (int i = 0; i < 16; ++i) { if (i + W < 16) gb[i + W] = __builtin_nontemporal_load((const v4u*)(GB + MG_OFF(i + W)));
            *(v4u*)(TMP + MG_OFF(i)) = pack8(up_lo(gb[i]) * acc[i >> 3][i & 1][(i >> 1) & 3][0], up_hi(gb[i]) * acc[i >> 3][i & 1][(i >> 1) & 3][1]); }
#undef MG_OFF
    }
};
struct EpiMergeA {
    static constexpr bool PERM = true, AFTER_DRAIN = false;
    bf16* MG; const bf16 *GA, *TMP;
    __device__ __forceinline__ void operator()(const f32x4 (&acc)[2][2][4][2], const Unit& u, int wr, int wc, int fr, int fq) const {
        const int row0 = u.pm * BM + wr * 64 + fr, col0 = u.pn * BM + wc * 32 + 8 * fq;
        constexpr int W = 6;
        v4u ga[16], tm[16];
#define MG_OFF(i_) ((size_t)(row0 + ((i_) >> 3) * HALF + (((i_) >> 1) & 3) * 16) * 1024 + col0 + ((i_) & 1) * HALF)
#define MG_LOAD(i_) do { const size_t o_ = MG_OFF(i_); ga[i_] = __builtin_nontemporal_load((const v4u*)(GA + o_)); tm[i_] = *(const v4u*)(TMP + o_); } while (0)
#pragma unroll
        for (int i = 0; i < W; ++i) MG_LOAD(i);
#pragma unroll
        for (int i = 0; i < 16; ++i) { if (i + W < 16) MG_LOAD(i + W);
            const f32x4 a0 = acc[i >> 3][i & 1][(i >> 1) & 3][0], a1 = acc[i >> 3][i & 1][(i >> 1) & 3][1];
            const f32x4 v0 = up_lo(tm[i]) + up_lo(ga[i]) * a0, v1 = up_hi(tm[i]) + up_hi(ga[i]) * a1;
            *(v4u*)(MG + MG_OFF(i)) = pack8(v0, v1); }
#undef MG_LOAD
#undef MG_OFF
    }
};
struct EpiMix {
    static constexpr bool PERM = true, AFTER_DRAIN = false;
    float* X1; const float* x; const float* modv;
    __device__ __forceinline__ void operator()(const f32x4 (&acc)[2][2][4][2], const Unit& u, int wr, int wc, int fr, int fq) const {
        const int row0 = u.pm * BM + wr * 64 + fr, col0 = u.pn * BM + wc * 32 + 8 * fq;
        const float* g1 = modv + ((u.pm * BM) / SEQ) * 6 * DM + 2 * DM + col0;
        f32x4 gv[2][2];
#pragma unroll
        for (int bj = 0; bj < 2; ++bj) { gv[bj][0] = *(const f32x4*)(g1 + bj * HALF); gv[bj][1] = *(const f32x4*)(g1 + bj * HALF + 4); }
        constexpr int W = 8;
        f32x4 xa[16], xb[16];
#define MX_OFF(i_) ((size_t)(row0 + ((i_) >> 3) * HALF + (((i_) >> 1) & 3) * 16) * 1024 + col0 + ((i_) & 1) * HALF)
#define MX_LOAD(i_) do { const size_t o_ = MX_OFF(i_); xa[i_] = __builtin_nontemporal_load((const f32x4*)(x + o_)); xb[i_] = __builtin_nontemporal_load((const f32x4*)(x + o_ + 4)); } while (0)
#pragma unroll
        for (int i = 0; i < W; ++i) MX_LOAD(i);
#pragma unroll
        for (int i = 0; i < 16; ++i) { if (i + W < 16) MX_LOAD(i + W);
            const size_t o = MX_OFF(i);
            *(f32x4*)(X1 + o) = xa[i] + acc[i >> 3][i & 1][(i >> 1) & 3][0] * gv[i & 1][0]; *(f32x4*)(X1 + o + 4) = xb[i] + acc[i >> 3][i & 1][(i >> 1) & 3][1] * gv[i & 1][1]; }
#undef MX_LOAD
#undef MX_OFF
    }
};

template <class Epi>
__device__ __forceinline__ void run_gemm(LAS unsigned char* lds, const bf16* A, const bf16* Bt, int N, int K, const Epi& E) {
    pg8::Gemm g{A, Bt, T, N, K}; pg8::StaticOrder S; S.init(T, N, (int)gridDim.x, (int)blockIdx.x);
    pg8::gemm_phase<Epi, pg8::StaticOrder, true, true>(lds, g, S, E);
}
}
namespace mk {
__device__ __forceinline__ void mod_phase(KP p, LAS unsigned char* L) {
    LAS float* sc = (LAS float*)L;
    LAS float* part = sc + 2048;
    float* modv = (float*)(p->ws + WS_MODV);
    const int tid = threadIdx.x, lane = tid & 63, w = tid >> 6;
    if (blockIdx.x >= 128 && gridDim.x >= 128) return;
    for (int i = tid; i < 2048; i += NTHR) sc[i] = siluf_(p->c[i]);
    __syncthreads();
    for (int blk = blockIdx.x; blk < 128; blk += gridDim.x) {
        const int j = blk * 48 + lane; float a0 = 0.f, a1 = 0.f;
        if (lane < 48) {
#pragma unroll 32
            for (int k = w * 128; k < w * 128 + 128; ++k) { const float wv = __builtin_nontemporal_load(p->w_ada + (size_t)k * 6 * DM + j); a0 += sc[k] * wv; a1 += sc[1024 + k] * wv; }
        }
        part[(w * 2 + 0) * 64 + lane] = a0; part[(w * 2 + 1) * 64 + lane] = a1;
        __syncthreads();
        if (tid < 128) { const int b = tid >> 6; float s = 0.f;
#pragma unroll
            for (int ww = 0; ww < 8; ++ww) s += part[(ww * 2 + b) * 64 + lane];
            if (lane < 48) modv[b * 6 * DM + j] = s + p->b_ada[j]; }
        __syncthreads();
    }
}
__device__ __forceinline__ void rope_phase(KP p) {
    float* rope = (float*)(p->ws + WS_ROPE);
    for (int i = blockIdx.x * NTHR + threadIdx.x; i < T * 32; i += gridDim.x * NTHR) {
        const int t = i >> 5, f = i & 31;
        const float inv = powf(10000.0f, -(float)f / 32.0f);
        const float ang = (float)p->positions[t] * inv;
        float sn, cs; sincosf(ang, &sn, &cs);
        rope[2 * i] = cs; rope[2 * i + 1] = sn;
    }
}
__device__ __forceinline__ void conv_wdt(KP p, LAS unsigned char* lds) {
    const int lane = threadIdx.x & 63, wv = threadIdx.x >> 6, gw = blockIdx.x * NWAVE + wv;
    if (gw < 16) transpose_item(p->w_in, INW, gw * 64, C_DT, (bf16*)(p->ws + WS_WTDT), 1024, 0, (LAS float*)(lds + wv * 16384), lane);
}
__device__ __forceinline__ void h_dt_phase(KP p, LAS unsigned char* L) {
    unsigned char* ws = p->ws;
    const float* modv = (const float*)(ws + WS_MODV); bf16* H = (bf16*)(ws + WS_H); float* DTP = (float*)(ws + WS_DTP); const bf16* WT = (const bf16*)(ws + WS_WTDT);
    constexpr int WP = 2064;
    const int tid = threadIdx.x, lane = tid & 63, w = tid >> 6, r = lane & 15, q = lane >> 4;
    for (int i = tid; i < 32 * 128; i += NTHR) { const int n = i >> 7, c16 = i & 127; *(LAS v4u*)(L + n * WP + c16 * 16) = *(const v4u*)(WT + n * 1024 + c16 * 8); }
    LAS float* GT = (LAS float*)(L + 69632);
    for (int i = tid; i < 2 * 1024; i += NTHR) { const int bb = i >> 10, k = i & 1023; GT[bb * 2048 + k] = p->norm1_g[k] * (1.f + modv[bb * 6 * DM + DM + k]); GT[bb * 2048 + 1024 + k] = modv[bb * 6 * DM + k]; }
    __syncthreads();
    const int gw = blockIdx.x * NWAVE + w, ngw = gridDim.x * NWAVE;
    for (int grp = gw; grp < T / 8; grp += ngw) {
        const int row = grp * 8 + (r & 7), b = row / SEQ; const bool own = r < 8;
        const float* xr = p->x + (size_t)row * DM + 8 * q;
        float ss = 0.f;
#pragma unroll 16
        for (int ks = 0; ks < 32; ++ks) { const f32x4 a = *(const f32x4*)(xr + 32 * ks), c = *(const f32x4*)(xr + 32 * ks + 4); const f32x4 s2 = a * a + c * c; ss += (s2[0] + s2[1]) + (s2[2] + s2[3]); }
        ss += __shfl_xor(ss, 16); ss += __shfl_xor(ss, 32);
        const float rs = rsqrtf(ss * (1.f / DM) + EPS);
        const LAS float* gt = GT + b * 2048 + 8 * q;
        f32x4 d0 = {0.f, 0.f, 0.f, 0.f}, d1 = {0.f, 0.f, 0.f, 0.f};
        asm volatile("" : "+v"(d0), "+v"(d1));
        bf16* hr = H + (size_t)row * DM + 8 * q; unsigned char* h8r = ws + WS_H8 + (size_t)row * DM + 8 * q;
        f32x4 xa[2][8], xc[2][8];
#define HD_LOAD(ch_) do { _Pragma("unroll") for (int i = 0; i < 8; ++i) { xa[(ch_) & 1][i] = *(const f32x4*)(xr + 32 * (8 * (ch_) + i)); xc[(ch_) & 1][i] = *(const f32x4*)(xr + 32 * (8 * (ch_) + i) + 4); } } while (0)
        HD_LOAD(0);
#pragma unroll
        for (int ch = 0; ch < 4; ++ch) {
            if (ch < 3) HD_LOAD(ch + 1);
#pragma unroll
            for (int i = 0; i < 8; ++i) { const int ks = 8 * ch + i;
                const f32x4 g0 = *(const LAS f32x4*)(gt + 32 * ks), g1 = *(const LAS f32x4*)(gt + 32 * ks + 4), h0 = *(const LAS f32x4*)(gt + 1024 + 32 * ks), h1 = *(const LAS f32x4*)(gt + 1024 + 32 * ks + 4);
                const f32x4 u0 = xa[ch & 1][i] * rs * g0 + h0, u1 = xc[ch & 1][i] * rs * g1 + h1;
                const v4u hw = pack8(u0, u1);
                if (own) { *(v4u*)(hr + 32 * ks) = hw; v2u h8; h8.x = pk4_fp8(clamp8(u0[0]), clamp8(u0[1]), clamp8(u0[2]), clamp8(u0[3])); h8.y = pk4_fp8(clamp8(u1[0]), clamp8(u1[1]), clamp8(u1[2]), clamp8(u1[3])); *(v2u*)(h8r + 32 * ks) = h8; }
                const bf16x8 hf = __builtin_bit_cast(bf16x8, hw);
                const bf16x8 w0 = *(const LAS bf16x8*)(L + r * WP + (32 * ks + 8 * q) * 2), w1 = *(const LAS bf16x8*)(L + (16 + r) * WP + (32 * ks + 8 * q) * 2);
                d0 = __builtin_amdgcn_mfma_f32_16x16x32_bf16(w0, hf, d0, 0, 0, 0); d1 = __builtin_amdgcn_mfma_f32_16x16x32_bf16(w1, hf, d1, 0, 0, 0); }
        }
#undef HD_LOAD
        const f32x4 b0 = *(const f32x4*)(p->dt_bias + 4 * q), b1 = *(const f32x4*)(p->dt_bias + 16 + 4 * q);
        f32x4 o0, o1;
#pragma unroll
        for (int i = 0; i < 4; ++i) { o0[i] = softplusf_(d0[i] + b0[i]); o1[i] = softplusf_(d1[i] + b1[i]); }
        if (own) { *(f32x4*)(DTP + (size_t)row * 32 + 4 * q) = o0; *(f32x4*)(DTP + (size_t)row * 32 + 16 + 4 * q) = o1; }
    }
}
}
namespace mk {
__device__ __forceinline__ void attn_phase(KP p, unsigned char* lds) {
    unsigned char* ws = p->ws;
    const bf16* Q = (const bf16*)(ws + WS_Q); const bf16* K = (const bf16*)(ws + WS_K); const bf16* V = (const bf16*)(ws + WS_V);
    bf16* SCR = (bf16*)(ws + WS_D) + (size_t)blockIdx.x * 65536;
    bf16* YA = (bf16*)(ws + WS_H);
    const int G = gridDim.x, bx = blockIdx.x, vcu = (G % 8 == 0) ? (bx % 8) * (G / 8) + bx / 8 : bx;
    for (int j = vcu * 4; j < 256 * 4; j += (j & 3) == 3 ? (G - 1) * 4 + 1 : 1) {
        const int v = j >> 2, i = (j >> 1) & 1, m = j & 1, bh = v >> 4, s = v & 15, qb = i ? 31 - s : s, b = bh >> 3, h = bh & 7;
        attn_body::attn_unit<8>(b, h * 2 + m, qb, h * 128, Q, K, V, SCR + m * 128, 256, (char*)lds);
        if (m == 1) {
            asm volatile("s_waitcnt vmcnt(0)" ::: "memory"); __syncthreads();
            const int tid = threadIdx.x, row = tid >> 1, half = tid & 1;
            float lam;
            { float a = 0.f, bq = 0.f; for (int i = 0; i < 64; ++i) { a += p->lambda_qk[i] * p->lambda_qk[64 + i]; bq += p->lambda_qk[128 + i] * p->lambda_qk[192 + i]; } lam = __expf(a) - __expf(bq) + LAMBDA_INIT; }
            const v4u* s0 = (const v4u*)(SCR + row * 256 + half * 64); const v4u* s1 = (const v4u*)(SCR + row * 256 + 128 + half * 64);
            float ss = 0.f;
            bf16* yo = YA + (size_t)(b * SEQ + qb * 256 + row) * 1024 + h * 128 + half * 64; const float* g = p->subln_g + half * 64;
            v4u av[8], bv[8]; f32x4 g0[8], g1[8];
#pragma unroll
            for (int c = 0; c < 8; ++c) { av[c] = s0[c]; bv[c] = s1[c]; g0[c] = *(const f32x4*)(g + 8 * c); g1[c] = *(const f32x4*)(g + 8 * c + 4); }
#pragma unroll
            for (int c = 0; c < 8; ++c) { const f32x4 d0 = up_lo(av[c]) - lam * up_lo(bv[c]), d1 = up_hi(av[c]) - lam * up_hi(bv[c]); const f32x4 q = d0 * d0 + d1 * d1; ss += (q[0] + q[1]) + (q[2] + q[3]); }
            ss += __shfl_xor(ss, 1);
            const float rr = __builtin_amdgcn_rsqf(ss * (1.f / 128.f) + EPS) * (1.f - LAMBDA_INIT);
#pragma unroll
            for (int c = 0; c < 8; ++c) { const f32x4 d0 = (up_lo(av[c]) - lam * up_lo(bv[c])) * rr * g0[c], d1 = (up_hi(av[c]) - lam * up_hi(bv[c])) * rr * g1[c];
                *(v4u*)(yo + 8 * c) = pack8(d0, d1); }
            __syncthreads();
        }
    }
}
}
namespace mk {
constexpr int LM_OFF = 131072;
constexpr int CW_ECNT = 8192;
constexpr float Y_SCALE = 32.f;

__device__ __forceinline__ void moe_tables(KP p, LAS unsigned char* L) {
    LAS int* cnts = (LAS int*)(L + LM_OFF); LAS int* tstart = cnts + 64;
    const int tid = threadIdx.x;
    __syncthreads();
    if (tid < 64) {
        const int c = (int)__hip_atomic_load((unsigned*)(p->ws + WS_CTL) + CW_ECNT + tid * 32, __ATOMIC_RELAXED, __HIP_MEMORY_SCOPE_AGENT);
        cnts[tid] = c; int incl = (c + 255) >> 8;
#pragma unroll
        for (int o = 1; o < 64; o <<= 1) { const int n = __shfl_up(incl, o); if (tid >= o) incl += n; }
        tstart[tid + 1] = incl; if (tid == 0) tstart[0] = 0; if (tid == 63) tstart[65] = incl + 64;
    }
    __syncthreads();
    LAS unsigned char* texp = (LAS unsigned char*)(tstart + 66);
    for (int t = tid; t < 640; t += NTHR) { int lo = 0, hi = 64;
#pragma unroll
        for (int it = 0; it < 7; ++it) { const int mid = (lo + hi + 1) >> 1; if (mid <= 64 && tstart[mid] <= t) lo = mid; else hi = mid - 1; }
        texp[t] = (unsigned char)lo; }
    __syncthreads();
}
__device__ __forceinline__ int find_expert(const LAS int* tstart, int tile) { return (int)((const LAS unsigned char*)(tstart + 66))[tile]; }

struct EpiAct {
    static constexpr bool PERM = true, AFTER_DRAIN = false;
    unsigned char* ws; const LAS int* cnts; const LAS int* tstart;
    __device__ __forceinline__ void operator()(const f32x4 (&acc)[2][2][4][2], const Unit& u, int wr, int wc, int fr, int fq) const {
        const int e = u.pn >> 1, h = u.pn & 1, j0 = (u.pm - tstart[e]) * 256, cnt = e < 64 ? cnts[e] : T;
        int fr0 = fr; asm volatile("" : "+v"(fr0)); fr = fr0;
        const float* lw = (const float*)(ws + WS_LW) + (size_t)(e & 63) * 16384;
        bf16* ACT = (bf16*)(ws + WS_ACT);
        float wv[8];
#pragma unroll
        for (int i = 0; i < 8; ++i) { const int pos = j0 + (i >> 2) * HALF + wr * 64 + (i & 3) * 16 + fr; wv[i] = lw[pos < cnt ? pos : 0]; }
#pragma unroll
        for (int ai = 0; ai < 2; ++ai)
#pragma unroll
            for (int m = 0; m < 4; ++m) { const int r = ai * HALF + wr * 64 + m * 16 + fr, pos = j0 + r;
                const float w = pos < cnt ? (e < 64 ? wv[ai * 4 + m] : 1.f) : 0.f;
                const float ws_ = w * (1.f / WGU_SCALE);
                const f32x4 v0 = silu4(acc[ai][0][m][0] * (1.f / WGU_SCALE)) * acc[ai][1][m][0] * ws_, v1 = silu4(acc[ai][0][m][1] * (1.f / WGU_SCALE)) * acc[ai][1][m][1] * ws_;
                *(v4u*)(ACT + ((size_t)u.pm * 256 + r) * 256 + h * 128 + wc * 32 + 8 * fq) = pack8(v0, v1); }
    }
};
struct MoeUpOrder {
    const LAS int* tstart; int vcu, G, U;
    __device__ __forceinline__ bool next(int i, Unit& u) const { const int ui = i * G + vcu; if (ui >= U) return false; const int tile = ui >> 1; u.pm = tile; u.pn = find_expert(tstart, tile) * 2 + (ui & 1); return true; }
    __device__ __forceinline__ void a_ready(const Unit&) const {}
    __device__ __forceinline__ void done(const Unit&) const {}
};
__device__ __forceinline__ void moe_up_phase(KP p, LAS unsigned char* L) {
    unsigned char* ws = p->ws;
    moe_tables(p, L);
    const LAS int* cnts = (const LAS int*)(L + LM_OFF); const LAS int* tstart = cnts + 64;
    LAS int* tokl = (LAS int*)(L + LM_OFF + 2048);
    const int G = gridDim.x, bx = blockIdx.x, vcu = (G % 8 == 0) ? (bx % 8) * (G / 8) + bx / 8 : bx, tid = threadIdx.x;
    const int* lists = (const int*)(ws + WS_LISTS);
    const int U = tstart[65] * 2;
    { int raw[4], alt[4]; bool val[4], rt[4];
#pragma unroll
      for (int n = 0; n < 4; ++n) { const int k = tid + NTHR * n, i = k >> 8, row = k & 255, ui = i * G + vcu; val[n] = ui < U;
          const int tile = val[n] ? ui >> 1 : 0, e = find_expert(tstart, tile), j0 = (tile - tstart[e]) * 256, cnt = e < 64 ? cnts[e] : T;
          rt[n] = e < 64 && j0 + row < cnt; alt[n] = e < 64 ? 0 : j0 + row;
          raw[n] = lists[rt[n] ? e * 16384 + j0 + row : 0]; }
#pragma unroll
      for (int n = 0; n < 4; ++n) if (val[n]) tokl[tid + NTHR * n] = rt[n] ? raw[n] >> 3 : alt[n]; }
    __syncthreads();
    MoeUpOrder S{tstart, vcu, G, U < 8 * G ? U : 8 * G};
    EpiAct E{ws, cnts, tstart};
    pg8::Gemm g{(const bf16*)(ws + WS_H2), (const bf16*)(ws + WS_WTGU), T, 65 * 512, 512};
    pg8::gemm_phase_gather<EpiAct, MoeUpOrder, true>(L, g, S, E, tokl);
}

struct MoeDownOrder {
    const LAS int* tstart; int vcu, G, U;
    __device__ __forceinline__ bool next(int i, Unit& u) const { const int ui = i * G + vcu; if (ui >= U) return false; const int tile = ui >> 2; u.pm = tile; u.pn = find_expert(tstart, tile) * 4 + (ui & 3); return true; }
    __device__ __forceinline__ void a_ready(const Unit&) const {}
    __device__ __forceinline__ void done(const Unit&) const {}
};
struct EpiDown {
    static constexpr bool PERM = true, AFTER_DRAIN = false;
    unsigned char* ws; const LAS int* cnts; const LAS int* tstart; const LAS int* pairl; int vcu, G;
    __device__ __forceinline__ void operator()(const f32x4 (&acc)[2][2][4][2], const Unit& u, int wr, int wc, int fr, int fq) const {
        int fr0 = fr, fq0 = fq; asm volatile("" : "+v"(fr0), "+v"(fq0)); fr = fr0; fq = fq0;
        const int e = u.pn >> 2, col0 = (u.pn & 3) * 256 + wc * 32 + 8 * fq, j0 = (u.pm - tstart[e]) * 256;
        if (e < 64) {
            unsigned char* Y = ws + WS_Y; const LAS int* pl = pairl + ((u.pm * 4 + (u.pn & 3) - vcu) / G) * 256;
#pragma unroll
            for (int ai = 0; ai < 2; ++ai)
#pragma unroll
                for (int m = 0; m < 4; ++m) { const int pr = pl[ai * HALF + wr * 64 + m * 16 + fr];
                    if (pr >= 0) { unsigned char* yrow = Y + (size_t)pr * 1024 + col0;
#pragma unroll
                        for (int bj = 0; bj < 2; ++bj) { const f32x4 a = acc[ai][bj][m][0] * Y_SCALE, b = acc[ai][bj][m][1] * Y_SCALE;
                            v2u o; o.x = pk4_fp8(clamp8(a[0]), clamp8(a[1]), clamp8(a[2]), clamp8(a[3])); o.y = pk4_fp8(clamp8(b[0]), clamp8(b[1]), clamp8(b[2]), clamp8(b[3]));
                            *(v2u*)(yrow + bj * HALF) = o; } } }
        } else {
            bf16* SH = (bf16*)(ws + WS_SH);
#pragma unroll
            for (int ai = 0; ai < 2; ++ai)
#pragma unroll
                for (int m = 0; m < 4; ++m) { bf16* rowp = SH + (size_t)(j0 + ai * HALF + wr * 64 + m * 16 + fr) * 1024 + col0;
#pragma unroll
                    for (int bj = 0; bj < 2; ++bj) *(v4u*)(rowp + bj * HALF) = pack8(acc[ai][bj][m][0], acc[ai][bj][m][1]); }
        }
    }
};
template <bool SPLIT> __device__ __forceinline__ void moe_down_phase(KP p, LAS unsigned char* L, const XcdBarrier& bar) {
    unsigned char* ws = p->ws;
    moe_tables(p, L);
    const LAS int* cnts = (const LAS int*)(L + LM_OFF); const LAS int* tstart = cnts + 64;
    const int G = gridDim.x, bx = blockIdx.x, vcu = (G % 8 == 0) ? (bx % 8) * (G / 8) + bx / 8 : bx;
    const int U = tstart[65] * 4;
    LAS int* pairl = (LAS int*)(L + LM_OFF + 2048);
    { const int* lists = (const int*)(ws + WS_LISTS); const int tid = threadIdx.x;
      int raw[6], alt[6]; bool val[6], rt[6];
#pragma unroll
      for (int n = 0; n < 6; ++n) { const int k = tid + NTHR * n, i = k >> 8, row = k & 255, ui = i * G + vcu; val[n] = ui < U;
          const int tile = val[n] ? ui >> 2 : 0, e = find_expert(tstart, tile), j0 = (tile - tstart[e]) * 256;
          rt[n] = e < 64 && j0 + row < cnts[e < 64 ? e : 0]; alt[n] = e < 64 ? -1 : 0;
          raw[n] = lists[rt[n] ? e * 16384 + j0 + row : 0]; }
#pragma unroll
      for (int n = 0; n < 6; ++n) if (val[n]) pairl[tid + NTHR * n] = rt[n] ? raw[n] : alt[n];
      __syncthreads(); }
    if (SPLIT) xcd_barrier_wait(bar);
    MoeDownOrder S{tstart, vcu, G, U < 12 * G ? U : 12 * G};
    EpiDown E{ws, cnts, tstart, pairl, vcu, G};
    pg8::Gemm g{(const bf16*)(ws + WS_ACT), (const bf16*)(ws + WS_WTD), 640 * 256, 65 * 1024, 256};
    pg8::gemm_phase<EpiDown, MoeDownOrder, true, true>(L, g, S, E);
}

__device__ __forceinline__ void final_phase(KP p) {
    unsigned char* ws = p->ws;
    const float* modv = (const float*)(ws + WS_MODV); const bf16* SH = (const bf16*)(ws + WS_SH); const unsigned char* Y = ws + WS_Y;
    const int lane = threadIdx.x & 63, gw = blockIdx.x * NWAVE + (threadIdx.x >> 6), ngw = gridDim.x * NWAVE, c0 = 16 * lane;
    for (int t = gw; t < T; t += 2 * ngw) {
        const int t1 = t + ngw < T ? t + ngw : t;
        v4u y0[8], y1[8];
#pragma unroll
        for (int s = 0; s < 8; ++s) { y0[s] = __builtin_nontemporal_load((const v4u*)(Y + ((size_t)t * 8 + s) * 1024 + c0)); y1[s] = __builtin_nontemporal_load((const v4u*)(Y + ((size_t)t1 * 8 + s) * 1024 + c0)); }
        const v4u h00 = __builtin_nontemporal_load((const v4u*)(SH + (size_t)t * DM + c0)), h01 = __builtin_nontemporal_load((const v4u*)(SH + (size_t)t * DM + c0 + 8)), h10 = __builtin_nontemporal_load((const v4u*)(SH + (size_t)t1 * DM + c0)), h11 = __builtin_nontemporal_load((const v4u*)(SH + (size_t)t1 * DM + c0 + 8));
        f32x4 x0[4], x1[4], g0[4], g1[4];
#pragma unroll
        for (int i = 0; i < 4; ++i) { x0[i] = __builtin_nontemporal_load((const f32x4*)(p->out + (size_t)t * DM + c0 + 4 * i)); x1[i] = __builtin_nontemporal_load((const f32x4*)(p->out + (size_t)t1 * DM + c0 + 4 * i));
            g0[i] = *(const f32x4*)(modv + (t / SEQ) * 6 * DM + 5 * DM + c0 + 4 * i); g1[i] = *(const f32x4*)(modv + (t1 / SEQ) * 6 * DM + 5 * DM + c0 + 4 * i); }
        f32x4 a0[4], a1[4];
#pragma unroll
        for (int i = 0; i < 4; ++i) { a0[i] = (f32x4){0.f, 0.f, 0.f, 0.f}; a1[i] = (f32x4){0.f, 0.f, 0.f, 0.f}; }
#pragma unroll
        for (int s = 0; s < 8; ++s)
#pragma unroll
            for (int i = 0; i < 4; ++i) { const int w0 = (int)(i == 0 ? y0[s].x : (i == 1 ? y0[s].y : (i == 2 ? y0[s].z : y0[s].w))), w1 = (int)(i == 0 ? y1[s].x : (i == 1 ? y1[s].y : (i == 2 ? y1[s].z : y1[s].w)));
                const f32x2 l0 = __builtin_amdgcn_cvt_pk_f32_fp8(w0, false), u0 = __builtin_amdgcn_cvt_pk_f32_fp8(w0, true), l1 = __builtin_amdgcn_cvt_pk_f32_fp8(w1, false), u1 = __builtin_amdgcn_cvt_pk_f32_fp8(w1, true);
                a0[i] += (f32x4){l0.x, l0.y, u0.x, u0.y}; a1[i] += (f32x4){l1.x, l1.y, u1.x, u1.y}; }
        const f32x4 s0[4] = {up_lo(h00), up_hi(h00), up_lo(h01), up_hi(h01)}, s1[4] = {up_lo(h10), up_hi(h10), up_lo(h11), up_hi(h11)};
#pragma unroll
        for (int i = 0; i < 4; ++i) { *(f32x4*)(p->out + (size_t)t * DM + c0 + 4 * i) = x0[i] + g0[i] * (a0[i] * (1.f / Y_SCALE) + s0[i]);
            *(f32x4*)(p->out + (size_t)t1 * DM + c0 + 4 * i) = x1[i] + g1[i] * (a1[i] * (1.f / Y_SCALE) + s1[i]); }
    }
}
}
namespace mk {
constexpr size_t WS_WRH = 22 * MiB + 256 * 1024, WS_WRL = 22 * MiB + 512 * 1024;
constexpr int CW_QCONV = 24;
__device__ __forceinline__ void conv_router(KP p, LAS unsigned char* lds) {
    const int lane = threadIdx.x & 63, wv = threadIdx.x >> 6, gw = blockIdx.x * NWAVE + wv;
    if (gw < 16 || gw >= 48) return;
    const int it = gw - 16, k0 = (it >> 1) * 64, n0 = (it & 1) * 32;
    LAS float* scr = (LAS float*)(lds + wv * 16384);
    bf16* WH = (bf16*)(p->ws + WS_WRH);
#pragma unroll 8
    for (int i = 0; i < 32; ++i) { const int kk = 2 * i + (lane >> 5); scr[kk * 33 + (lane & 31)] = p->w_router[(size_t)(k0 + kk) * 64 + n0 + (lane & 31)]; }
    asm volatile("s_waitcnt lgkmcnt(0)" ::: "memory");
    const int c = lane & 7;
#pragma unroll
    for (int j = 0; j < 4; ++j) { const int n = (lane >> 3) + 8 * j; const LAS float* s = scr + (8 * c) * 33 + n;
        float v[8]; unsigned h[8];
#pragma unroll
        for (int e = 0; e < 8; ++e) { v[e] = s[e * 33]; h[e] = f2bf(v[e]); }
        v4u oh, ol; oh.x = h[0] | (h[1] << 16); oh.y = h[2] | (h[3] << 16); oh.z = h[4] | (h[5] << 16); oh.w = h[6] | (h[7] << 16);
        ol.x = pk2(v[0] - bf2f(h[0]), v[1] - bf2f(h[1])); ol.y = pk2(v[2] - bf2f(h[2]), v[3] - bf2f(h[3])); ol.z = pk2(v[4] - bf2f(h[4]), v[5] - bf2f(h[5])); ol.w = pk2(v[6] - bf2f(h[6]), v[7] - bf2f(h[7]));
        const int kk = k0 + 8 * c, nn = n0 + n;
        bf16* fp = WH + (size_t)(((((kk >> 7) * 4 + ((kk >> 5) & 3)) * 4 + (nn >> 4)) * 2) * 64 + ((kk >> 3) & 3) * 16 + (nn & 15)) * 8;
        *(v4u*)fp = oh; *(v4u*)(fp + 512) = ol; }
}

__device__ __forceinline__ TrItem expert_item(KP p, int it) {
    const int e = it / 384, rr = it % 384;
    if (rr < 256) { const bool up = rr >= 128; const int qq = rr & 127, kb = qq >> 3, nb = qq & 7, f0 = nb * 32;
        const float* W = e < 64 ? (up ? p->w_exp_up : p->w_exp_gate) + (size_t)e * DM * EDIM : (up ? p->w_sh_up : p->w_sh_gate);
        return TrItem{W, (size_t)EDIM, kb * 64, f0, (bf16*)(p->ws + WS_WTGU + (size_t)e * 512 * 1024), (size_t)1024, 256 * (f0 >> 7) + (up ? 128 : 0) + (f0 & 127)}; }
    const int qq = rr - 256, kb = qq >> 5, nb = qq & 31;
    const float* W = e < 64 ? p->w_exp_down + (size_t)e * EDIM * DM : p->w_sh_down;
    return TrItem{W, (size_t)DM, kb * 64, nb * 32, (bf16*)(p->ws + WS_WTD) + (size_t)e * 1024 * 256, (size_t)256, nb * 32};
}
__device__ __forceinline__ void expert_finish(KP p, int it, const f32x4 (&v)[8], LAS float* scr, int lane) {
    if ((it % 384) < 256) transpose_finish8(expert_item(p, it), v, scr, lane, WGU_SCALE); else transpose_finish(expert_item(p, it), v, scr, lane);
}
constexpr int RT_NCONV = 24576;
template <bool CONV> __device__ __forceinline__ void route_phase3(KP p, LAS unsigned char* L) {
    unsigned char* ws = p->ws;
    int tid_ = threadIdx.x; asm volatile("" : "+v"(tid_));
    const int tid = tid_, lane = tid & 63, w = tid >> 6, r = lane & 15, q = lane >> 4;
    const float* modv = (const float*)(ws + WS_MODV); const float* X1 = p->out; bf16* H2 = (bf16*)(ws + WS_H2);
    const bf16* WH = (const bf16*)(ws + WS_WRH);
    int* lists = (int*)(ws + WS_LISTS); float* lw = (float*)(ws + WS_LW); unsigned* gcnt = (unsigned*)(ws + WS_CTL) + CW_ECNT;
    LAS float* plg = (LAS float*)L;
    LAS float* lg = plg + 8 * 1024;
    LAS float* psum = lg + 1024;
    LAS unsigned* lcnt = (LAS unsigned*)(L + LM_OFF);
    LAS unsigned* lbase = lcnt + 64;
    LAS unsigned* rec = lbase + 64;
    LAS float* recw = (LAS float*)(rec + 1024);
    const float rb = p->router_bias[lane];
    const int k0 = 128 * w + 8 * q;
    LAS float* cscr = (LAS float*)(L + 40960 + w * 8448);
    f32x4 cv[8];
    LAS float* GT = (LAS float*)(L + 110592);
    bf16x8 wA[8], wB[8];
#define RT_LOADW(buf_, ks_) do { _Pragma("unroll") for (int nb = 0; nb < 4; ++nb) { buf_[2 * nb] = *(const bf16x8*)(whb + ((ks_) * 4 + nb) * 1024); buf_[2 * nb + 1] = *(const bf16x8*)(whb + ((ks_) * 4 + nb) * 1024 + 512); } } while (0)
    __syncthreads();
    if (tid < 64) lcnt[tid] = 0u;
    int nit = 0, tb = -1;
    f32x4 xa[4], xc[4];
#define RT_LOADX(it_) do { int xo_ = r * DM + k0; asm volatile("" : "+v"(xo_)); const size_t ro_ = (size_t)((it_) * 16) * DM + xo_; _Pragma("unroll") for (int ks = 0; ks < 4; ++ks) { xa[ks] = __builtin_nontemporal_load((const f32x4*)(X1 + ro_ + 32 * ks)); xc[ks] = __builtin_nontemporal_load((const f32x4*)(X1 + ro_ + 32 * ks + 4)); } } while (0)
    if ((int)blockIdx.x < T / 16) RT_LOADX((int)blockIdx.x);
    if (CONV) transpose_load(expert_item(p, (int)blockIdx.x * 96 + w * 3), cv, lane);
    for (int it = blockIdx.x; it < T / 16; it += gridDim.x, ++nit) {
        const int row = it * 16 + r, b = (it * 16) / SEQ;
        const int cit = (((int)blockIdx.x * 4 + nit) * 8 + w) * 3;
        int wofs = w * 16384 + lane * 8; asm volatile("" : "+v"(wofs));
        const bf16* whb = WH + wofs;
        RT_LOADW(wA, 0); RT_LOADW(wB, 1);
        if (b != tb) { tb = b;
            int t2 = 2 * tid; asm volatile("" : "+v"(t2));
            const float* gp = p->norm2_g + t2; const float* scp = modv + b * 6 * DM + 4 * DM + t2; const float* shp = modv + b * 6 * DM + 3 * DM + t2;
            const f32x2 g = *(const f32x2*)gp, s = *(const f32x2*)scp, hh = *(const f32x2*)shp;
            *(LAS f32x2*)(GT + t2) = g * (1.f + s); *(LAS f32x2*)(GT + 1024 + t2) = hh; }
        __builtin_amdgcn_sched_barrier(0);
        float ss = 0.f;
#pragma unroll
        for (int ks = 0; ks < 4; ++ks) {
            const f32x4 s2 = xa[ks] * xa[ks] + xc[ks] * xc[ks]; ss += (s2[0] + s2[1]) + (s2[2] + s2[3]); }
        ss += __shfl_xor(ss, 16); ss += __shfl_xor(ss, 32);
        if (q == 0) psum[w * 16 + r] = ss;
        __syncthreads();
        if (CONV) expert_finish(p, cit, cv, cscr, lane);
        float tot = 0.f;
#pragma unroll
        for (int ww = 0; ww < 8; ++ww) tot += psum[ww * 16 + r];
        const float rs = rsqrtf(tot * (1.f / DM) + EPS);
        f32x4 acc[4];
#pragma unroll
        for (int nb = 0; nb < 4; ++nb) { acc[nb] = (f32x4){0.f, 0.f, 0.f, 0.f}; asm volatile("" : "+v"(acc[nb])); }
        unsigned char* hr = (unsigned char*)H2 + (size_t)row * DM + k0;
#pragma unroll
        for (int ks = 0; ks < 4; ++ks) {
            const LAS float* gq = GT + k0 + 32 * ks;
            const f32x4 g0 = *(const LAS f32x4*)gq, g1 = *(const LAS f32x4*)(gq + 4), h0 = *(const LAS f32x4*)(gq + 1024), h1 = *(const LAS f32x4*)(gq + 1028);
            const f32x4 v0 = xa[ks] * rs * g0 + h0, v1 = xc[ks] * rs * g1 + h1;
            const v4u hw = pack8(v0, v1);
            { v2u h8; h8.x = pk4_fp8(clamp8(v0[0]), clamp8(v0[1]), clamp8(v0[2]), clamp8(v0[3])); h8.y = pk4_fp8(clamp8(v1[0]), clamp8(v1[1]), clamp8(v1[2]), clamp8(v1[3])); *(v2u*)(hr + 32 * ks) = h8; }
            const v4u lwv = pack8(v0 - up_lo(hw), v1 - up_hi(hw));
            const bf16x8 hh = __builtin_bit_cast(bf16x8, hw), hl = __builtin_bit_cast(bf16x8, lwv);
#pragma unroll
            for (int nb = 0; nb < 4; ++nb) { const bf16x8 wh = (ks & 1) ? wB[2 * nb] : wA[2 * nb], wl = (ks & 1) ? wB[2 * nb + 1] : wA[2 * nb + 1];
                acc[nb] = __builtin_amdgcn_mfma_f32_16x16x32_bf16(wh, hh, acc[nb], 0, 0, 0);
                acc[nb] = __builtin_amdgcn_mfma_f32_16x16x32_bf16(wl, hh, acc[nb], 0, 0, 0);
                acc[nb] = __builtin_amdgcn_mfma_f32_16x16x32_bf16(wh, hl, acc[nb], 0, 0, 0); }
            __builtin_amdgcn_sched_barrier(0);
            if (ks == 0) { RT_LOADW(wA, 2); __builtin_amdgcn_sched_barrier(0); }
            if (ks == 1) { RT_LOADW(wB, 3); if (CONV) transpose_load(expert_item(p, cit + 1), cv, lane); __builtin_amdgcn_sched_barrier(0); }
        }
#pragma unroll
        for (int nb = 0; nb < 4; ++nb) *(LAS f32x4*)(plg + w * 1024 + r * 64 + 16 * nb + 4 * q) = acc[nb];
        if (it + (int)gridDim.x < T / 16) RT_LOADX(it + (int)gridDim.x);
        __syncthreads();
        if (CONV) { expert_finish(p, cit + 1, cv, cscr, lane); transpose_load(expert_item(p, cit + 2), cv, lane); }
#pragma unroll
        for (int i = 0; i < 2; ++i) { const int idx = tid + i * NTHR; float s = 0.f;
#pragma unroll
            for (int ww = 0; ww < 8; ++ww) s += plg[ww * 1024 + idx];
            lg[idx] = s; }
        __syncthreads();
        if (CONV) { expert_finish(p, cit + 2, cv, cscr, lane); transpose_load(expert_item(p, cit + 24), cv, lane); }
#pragma unroll 1
        for (int t2 = 0; t2 < 2; ++t2) {
            const int rr = 2 * w + t2;
            float a = lg[rr * 64 + lane];
            a = (a == a) ? fminf(fmaxf(a, -80.f), 80.f) : 0.f;
            const float score = 1.f / (1.f + __expf(-a)), choice = score + rb;
            int cg = 0;
#pragma unroll
            for (int i = 0; i < 8; ++i) { const float o = __shfl(choice, (lane & ~7) + i); cg += (o > choice || (o == choice && i < (lane & 7))) ? 1 : 0; }
            float gsum = cg < 2 ? choice : 0.f;
            gsum += __shfl_xor(gsum, 1); gsum += __shfl_xor(gsum, 2); gsum += __shfl_xor(gsum, 4);
            int grank = 0;
#pragma unroll
            for (int i = 0; i < 8; ++i) { const float o = __builtin_bit_cast(float, __builtin_amdgcn_readlane(__builtin_bit_cast(int, gsum), i * 8)); grank += (o > gsum || (o == gsum && i < (lane >> 3))) ? 1 : 0; }
            const bool elig = grank < 4;
            const float v = elig ? choice : -INFINITY;
            int rank = 0;
#pragma unroll
            for (int i = 0; i < 64; ++i) { const float o = __builtin_bit_cast(float, __builtin_amdgcn_readlane(__builtin_bit_cast(int, v), i)); rank += (o > v || (o == v && i < lane)) ? 1 : 0; }
            const bool sel = elig && rank < 8;
            const float wsum = wave_sum(sel ? score : 0.f);
            if (sel) { const unsigned lpos = __hip_atomic_fetch_add(&lcnt[lane], 1u, __ATOMIC_RELAXED, __HIP_MEMORY_SCOPE_WORKGROUP); const int rl = (nit * 16 + rr) * 8 + rank; rec[rl] = (unsigned)lane | (lpos << 8); recw[rl] = score / wsum * ROUTED_SCALE; }
        }
    }
#undef RT_LOADX
#undef RT_LOADW
    __syncthreads();
    if (tid < 64) { const unsigned c = lcnt[tid]; lbase[tid] = c ? __hip_atomic_fetch_add(gcnt + tid * 32, c, __ATOMIC_RELAXED, __HIP_MEMORY_SCOPE_AGENT) : 0u; }
    __syncthreads();
    for (int pi = tid; pi < nit * 128; pi += NTHR) { const unsigned rc = rec[pi]; const int e = rc & 63, pos = (int)(lbase[e] + (rc >> 8));
        const int itn = pi >> 7, token = ((int)blockIdx.x + itn * (int)gridDim.x) * 16 + ((pi >> 3) & 15);
        lists[e * 16384 + pos] = token * 8 + (pi & 7); lw[e * 16384 + pos] = recw[pi]; }
}
__device__ __forceinline__ void conv_expert_weights_q(KP p, LAS unsigned char* lds) {
    const int lane = threadIdx.x & 63, wv = threadIdx.x >> 6;
    LAS float* scr = (LAS float*)(lds + wv * 16384);
    unsigned* head = (unsigned*)(p->ws + WS_CTL) + CW_QCONV;
    constexpr int CH = 12, NIT = 65 * 384;
    __syncthreads();
    for (;;) {
        unsigned itu = 0u; if (lane == 0) itu = __hip_atomic_fetch_add(head, (unsigned)CH, __ATOMIC_RELAXED, __HIP_MEMORY_SCOPE_AGENT);
        const int it0 = (int)__builtin_amdgcn_readfirstlane(itu) + (gridDim.x == 256 ? RT_NCONV : 0);
        if (it0 >= NIT) break;
        f32x4 va[8], vb[8];
        transpose_load(expert_item(p, it0), va, lane);
        for (int it = it0; it < it0 + CH; it += 2) {
            transpose_load(expert_item(p, it + 1), vb, lane);
            if ((it % 384) < 256) transpose_finish8(expert_item(p, it), va, scr, lane, WGU_SCALE); else transpose_finish(expert_item(p, it), va, scr, lane);
            if (it + 2 < it0 + CH) transpose_load(expert_item(p, it + 2), va, lane);
            if (((it + 1) % 384) < 256) transpose_finish8(expert_item(p, it + 1), vb, scr, lane, WGU_SCALE); else transpose_finish(expert_item(p, it + 1), vb, scr, lane);
        }
    }
}
}
namespace ssd {
using mk::cvtpk; using mk::fsig;
constexpr int PITCH = 272;
__device__ __forceinline__ v2u pack4(f32x4 a) { v2u o; o.x = cvtpk(a[0], a[1]); o.y = cvtpk(a[2], a[3]); return o; }
__device__ __forceinline__ f32x4 unpack4(v2u w) { return (f32x4){__builtin_bit_cast(float, w.x << 16), __builtin_bit_cast(float, w.x & 0xffff0000u), __builtin_bit_cast(float, w.y << 16), __builtin_bit_cast(float, w.y & 0xffff0000u)}; }
__device__ __forceinline__ float fsilu(float x) { return x * fsig(x); }
__device__ __forceinline__ f32x4 zero4() { f32x4 z = {0.f, 0.f, 0.f, 0.f}; asm volatile("" : "+v"(z)); return z; }
__device__ __forceinline__ f32x4 mfma16(bf16x8 a, bf16x8 b, f32x4 c) { const f32x4 d = __builtin_amdgcn_mfma_f32_16x16x32_bf16(a, b, c, 0, 0, 0); asm volatile("" :: "v"(a), "v"(b)); return d; }

template <int NCH> struct StageT { unsigned w[NCH / 64][11]; };
template <int NCH>
__device__ __forceinline__ void stage_T_load(const bf16* XBC, int t0, int chg, StageT<NCH>& s) {
    constexpr int NCP = NCH / 2;
    const int tid = threadIdx.x, cp = tid % NCP, ch = chg + 2 * cp;
#pragma unroll
    for (int n = 0; n < NCH / 64; ++n) { const int l0 = ((tid + n * NTHR) / NCP) * 8;
#pragma unroll
        for (int i = 0; i < 11; ++i) s.w[n][i] = *(const unsigned*)(XBC + (long)(t0 + l0 - 3 + i) * CONV_DIM + ch); }
}
template <int NCH, bool SCALE>
__device__ __forceinline__ void stage_T_finish(KP p, bool first, int chg, LAS unsigned char* dst, const LAS float* scale, const StageT<NCH>& s) {
    constexpr int NCP = NCH / 2;
    const int tid = threadIdx.x, cp = tid % NCP, ch = chg + 2 * cp;
    const float a0 = p->conv_w[ch], a1 = p->conv_w[3072 + ch], a2 = p->conv_w[6144 + ch], a3 = p->conv_w[9216 + ch], ab = p->conv_b[ch];
    const float b0 = p->conv_w[ch + 1], b1 = p->conv_w[3072 + ch + 1], b2 = p->conv_w[6144 + ch + 1], b3 = p->conv_w[9216 + ch + 1], bb = p->conv_b[ch + 1];
#pragma unroll
    for (int n = 0; n < NCH / 64; ++n) {
        const int l0 = ((tid + n * NTHR) / NCP) * 8;
        float ra[11], rb[11];
#pragma unroll
        for (int i = 0; i < 11; ++i) { const unsigned w = (first && l0 - 3 + i < 0) ? 0u : s.w[n][i];
            ra[i] = __builtin_bit_cast(float, w << 16); rb[i] = __builtin_bit_cast(float, w & 0xffff0000u); }
        float oa[8], ob[8];
#pragma unroll
        for (int i = 0; i < 8; ++i) { oa[i] = fsilu(ab + a0 * ra[i] + a1 * ra[i + 1] + a2 * ra[i + 2] + a3 * ra[i + 3]); ob[i] = fsilu(bb + b0 * rb[i] + b1 * rb[i + 1] + b2 * rb[i + 2] + b3 * rb[i + 3]); }
        if (SCALE) { const LAS float* sc = scale + ((2 * cp) >> 6) * 128 + l0; const f32x4 s0 = *(const LAS f32x4*)sc, s1 = *(const LAS f32x4*)(sc + 4);
#pragma unroll
            for (int i = 0; i < 4; ++i) { oa[i] *= s0[i]; ob[i] *= s0[i]; oa[4 + i] *= s1[i]; ob[4 + i] *= s1[i]; } }
        v4u wa, wb; wa.x = cvtpk(oa[0], oa[1]); wa.y = cvtpk(oa[2], oa[3]); wa.z = cvtpk(oa[4], oa[5]); wa.w = cvtpk(oa[6], oa[7]);
        wb.x = cvtpk(ob[0], ob[1]); wb.y = cvtpk(ob[2], ob[3]); wb.z = cvtpk(ob[4], ob[5]); wb.w = cvtpk(ob[6], ob[7]);
        *(LAS v4u*)(dst + (2 * cp) * PITCH + l0 * 2) = wa; *(LAS v4u*)(dst + (2 * cp + 1) * PITCH + l0 * 2) = wb;
    }
}
__device__ __forceinline__ void stage_N(KP p, const bf16* XBC, int t0, bool first, int chg, LAS unsigned char* dst) {
    const int tid = threadIdx.x, cq = tid & 15, ch = chg + 8 * cq;
    f32x4 w[4][2], bs[2];
#pragma unroll
    for (int j = 0; j < 4; ++j) { w[j][0] = *(const f32x4*)(p->conv_w + j * CONV_DIM + ch); w[j][1] = *(const f32x4*)(p->conv_w + j * CONV_DIM + ch + 4); }
    bs[0] = *(const f32x4*)(p->conv_b + ch); bs[1] = *(const f32x4*)(p->conv_b + ch + 4);
    v4u raw[4][4];
#pragma unroll
    for (int it = 0; it < 4; ++it)
#pragma unroll
        for (int j = 0; j < 4; ++j) raw[it][j] = *(const v4u*)(XBC + (long)(t0 + (tid >> 4) + 32 * it - 3 + j) * CONV_DIM + ch);
#pragma unroll
    for (int it = 0; it < 4; ++it) { const int l = (tid >> 4) + 32 * it;
        f32x4 o0 = bs[0], o1 = bs[1];
#pragma unroll
        for (int j = 0; j < 4; ++j) { const bool off = first && (l - 3 + j < 0); const v4u rw = off ? (v4u){0u, 0u, 0u, 0u} : raw[it][j];
            o0 += w[j][0] * mk::up_lo(rw); o1 += w[j][1] * mk::up_hi(rw); }
        o0 = mk::silu4(o0); o1 = mk::silu4(o1);
        *(LAS v4u*)(dst + l * PITCH + cq * 16) = mk::pack8(o0, o1); }
}
__device__ __forceinline__ void acum_setup(KP p, const float* DTP, int t0, int g, LAS float* s_acum, LAS float* s_dt) {
    const int lane = threadIdx.x & 63, w = threadIdx.x >> 6;
    const float A = -__expf(p->a_log[g * 8 + w]);
    const float d0 = DTP[(size_t)(t0 + 2 * lane) * 32 + g * 8 + w], d1 = DTP[(size_t)(t0 + 2 * lane + 1) * 32 + g * 8 + w];
    const float v1 = d1 * A; float s = d0 * A + v1;
#pragma unroll
    for (int o = 1; o < 64; o <<= 1) { const float n = __shfl_up(s, o); if (lane >= o) s += n; }
    s_acum[w * 128 + 2 * lane + 1] = s; s_acum[w * 128 + 2 * lane] = s - v1; s_dt[w * 128 + 2 * lane] = d0; s_dt[w * 128 + 2 * lane + 1] = d1;
}

__device__ __forceinline__ void states_phase(KP p, LAS unsigned char* L) {
    unsigned char* ws = p->ws;
    const bf16* XBC = (const bf16*)(ws + WS_B); const float* DTP = (const float*)(ws + WS_DTP); bf16* ST = (bf16*)(ws + WS_C); float* CD = (float*)(ws + WS_CD);
    LAS float* s_acum = (LAS float*)L; LAS float* s_w = s_acum + 1024; LAS unsigned char* BT = L + 8192; LAS unsigned char* XT = L + 43008;
    const int tid = threadIdx.x, lane = tid & 63, w = __builtin_amdgcn_readfirstlane(tid >> 6), r = lane & 15, q = lane >> 4;
    for (int u = blockIdx.x; u < BATCH * SSD_NC * SSD_G; u += gridDim.x) {
        const int b = u >> 8, c = (u >> 2) & 63, g = u & 3, t0 = b * SEQ + c * 128;
        __syncthreads();
        acum_setup(p, DTP, t0, g, s_acum, s_w);
        __syncthreads();
        for (int i = tid; i < 1024; i += NTHR) s_w[i] = s_w[i] * __expf(s_acum[(i >> 7) * 128 + 127] - s_acum[i]);
        if (tid < 8) CD[(b * 64 + c) * 32 + g * 8 + tid] = __expf(s_acum[tid * 128 + 127]);
        StageT<256> sx;
        { StageT<128> sb; stage_T_load<128>(XBC, t0, DIN + g * 128, sb); stage_T_load<256>(XBC, t0, g * 512, sx); stage_T_finish<128, false>(p, c == 0, DIN + g * 128, BT, nullptr, sb); }
#pragma unroll
        for (int pass = 0; pass < 2; ++pass) {
            __syncthreads();
            stage_T_finish<256, true>(p, c == 0, g * 512 + pass * 256, XT, s_w + pass * 512, sx);
            if (pass == 0) stage_T_load<256>(XBC, t0, g * 512 + 256, sx);
            __syncthreads();
            const int hl = w >> 1, nh = w & 1;
            f32x4 acc[4][4];
#pragma unroll
            for (int i = 0; i < 4; ++i)
#pragma unroll
                for (int j = 0; j < 4; ++j) acc[i][j] = zero4();
#pragma unroll
            for (int ks = 0; ks < 4; ++ks) {
                bf16x8 bfr[4], xfr[4];
#pragma unroll
                for (int nb = 0; nb < 4; ++nb) bfr[nb] = *(const LAS bf16x8*)(BT + (64 * nh + 16 * nb + r) * PITCH + (32 * ks + 8 * q) * 2);
#pragma unroll
                for (int pb = 0; pb < 4; ++pb) xfr[pb] = *(const LAS bf16x8*)(XT + (64 * hl + 16 * pb + r) * PITCH + (32 * ks + 8 * q) * 2);
#pragma unroll
                for (int pb = 0; pb < 4; ++pb)
#pragma unroll
                    for (int nb = 0; nb < 4; ++nb) acc[pb][nb] = mfma16(bfr[nb], xfr[pb], acc[pb][nb]);
            }
            bf16* base = ST + ((size_t)(b * 64 + c) * 32 + g * 8 + 4 * pass + hl) * 8192;
#pragma unroll
            for (int pb = 0; pb < 4; ++pb)
#pragma unroll
                for (int nb = 0; nb < 4; ++nb) *(v2u*)(base + (16 * pb + r) * 128 + 64 * nh + 16 * nb + 4 * q) = pack4(acc[pb][nb]);
        }
    }
}

__device__ __forceinline__ void scan_phase(KP p) {
    const bf16* ST = (const bf16*)(p->ws + WS_C); bf16* PREV = (bf16*)p->out; const float* CD = (const float*)(p->ws + WS_CD);
    for (int gi = blockIdx.x * NTHR + threadIdx.x; gi < BATCH * SSD_H * SSD_P * 32; gi += gridDim.x * NTHR) {
        const int n4 = gi & 31, pp = (gi >> 5) & 63, h = (gi >> 11) & 31, b = gi >> 16;
        const size_t boff = ((size_t)(b * 64) * 32 + h) * 8192 + pp * 128 + n4 * 4; const bf16* base = ST + boff; bf16* obase = PREV + boff;
        f32x4 run = {0.f, 0.f, 0.f, 0.f};
        for (int c0 = 0; c0 < 64; c0 += 8) {
            v2u ld[8]; float cd[8];
#pragma unroll
            for (int i = 0; i < 8; ++i) { ld[i] = __builtin_nontemporal_load((const v2u*)(base + (size_t)(c0 + i) * 32 * 8192)); cd[i] = CD[(b * 64 + c0 + i) * 32 + h]; }
#pragma unroll
            for (int i = 0; i < 8; ++i) { *(v2u*)(obase + (size_t)(c0 + i) * 32 * 8192) = pack4(run); run = run * cd[i] + unpack4(ld[i]); }
        }
    }
}

template <bool SPLIT> __device__ __forceinline__ void output_phase(KP p, LAS unsigned char* L, const XcdBarrier& bar) {
    unsigned char* ws = p->ws;
    const bf16* XBC = (const bf16*)(ws + WS_B); const float* DTP = (const float*)(ws + WS_DTP); const bf16* ST = (const bf16*)p->out; const bf16* ZS = (const bf16*)(ws + WS_A); bf16* YB = (bf16*)(ws + WS_YB);
    LAS float* s_acum = (LAS float*)L; LAS float* s_dt = s_acum + 1024;
    LAS unsigned char* CN = L + 8192; LAS unsigned char* BN = L + 43008;
    const int tid = threadIdx.x, lane = tid & 63, w = __builtin_amdgcn_readfirstlane(tid >> 6), r = lane & 15, q = lane >> 4;
    LAS unsigned char* MS = L + 77824 + w * (16 * PITCH);
    LAS float* s_tp = (LAS float*)(L + 112640);
    LAS float* s_dk = (LAS float*)(L + 126976);
    LAS float* s_g = (LAS float*)(L + 122880);
    for (int u = blockIdx.x; u < BATCH * SSD_NC * SSD_G; u += gridDim.x) {
        const int b = u >> 8, c = (u >> 2) & 63, g = u & 3, t0 = b * SEQ + c * 128, lrow = 16 * w + r;
        __syncthreads();
        acum_setup(p, DTP, t0, g, s_acum, s_dt);
        stage_N(p, XBC, t0, c == 0, DIN + 512 + g * 128, CN);
        stage_N(p, XBC, t0, c == 0, DIN + g * 128, BN);
        for (int i = lane; i < 16 * PITCH / 16; i += 64) *(LAS v4u*)(MS + i * 16) = (v4u){0u, 0u, 0u, 0u};
        for (int i = tid; i < 5 * 512; i += NTHR) { const int ti = i >> 9, ch = i & 511; s_tp[i] = ti < 4 ? p->conv_w[ti * CONV_DIM + g * 512 + ch] : p->conv_b[g * 512 + ch]; }
        if (tid < 8) { int t8 = tid; asm volatile("" : "+v"(t8)); s_dk[t8] = p->d_skip[g * 8 + t8]; }
        __syncthreads();
        for (int i = tid; i < 1024; i += NTHR) s_g[i] = __expf(s_acum[(i & ~15) + 15] - s_acum[i]);
        f32x4 cb[8];
#pragma unroll
        for (int sb = 0; sb < 8; ++sb) cb[sb] = zero4();
#pragma unroll
        for (int ks = 0; ks < 4; ++ks) { const bf16x8 cf = *(const LAS bf16x8*)(CN + lrow * PITCH + (32 * ks + 8 * q) * 2);
            bf16x8 bf[8];
#pragma unroll
            for (int sb = 0; sb < 8; ++sb) bf[sb] = *(const LAS bf16x8*)(BN + (16 * sb + r) * PITCH + (32 * ks + 8 * q) * 2);
#pragma unroll
            for (int sb = 0; sb < 8; ++sb) cb[sb] = mfma16(bf[sb], cf, cb[sb]); }
        bf16x8 cfr[4];
#pragma unroll
        for (int ks = 0; ks < 4; ++ks) cfr[ks] = *(const LAS bf16x8*)(CN + lrow * PITCH + (32 * ks + 8 * q) * 2);
        float ss = 0.f;
        const int cp = tid & 31, l0 = (tid >> 5) * 8;
        unsigned xr[11]; v4u pvr[2]; v2u zr[4];
#define S3_LOADS(j_) do { const int hd_ = g * 8 + (j_), ch_ = g * 512 + (j_) * 64 + 2 * cp; \
            _Pragma("unroll") for (int i = 0; i < 11; ++i) xr[i] = *(const unsigned*)(XBC + ((long)(t0 + l0 - 3 + i)) * CONV_DIM + ch_);     \
            { const bf16* src_ = ST + ((size_t)(b * 64 + c) * 32 + hd_) * 8192; _Pragma("unroll") for (int it = 0; it < 2; ++it) { const int idx = tid + it * NTHR; pvr[it] = __builtin_nontemporal_load((const v4u*)(src_ + (idx >> 4) * 128 + (idx & 15) * 8)); } } \
            { const size_t zo_ = (size_t)(t0 + lrow) * DIN + hd_ * 64 + 4 * q; _Pragma("unroll") for (int pb = 0; pb < 4; ++pb) zr[pb] = *(const v2u*)(ZS + zo_ + 16 * pb); } } while (0)
        if (SPLIT && u == (int)blockIdx.x) xcd_barrier_wait(bar);
        S3_LOADS(0);
        __syncthreads();
        for (int j = 0; j < 8; ++j) {
            const int hd = g * 8 + j;
            LAS unsigned char* XT = L + ((j & 1) ? 8192 : 43008); LAS unsigned char* PV = L + ((j & 1) ? 25600 : 60416);
            if (c == 0 && l0 == 0) { xr[0] = 0u; xr[1] = 0u; xr[2] = 0u; }
            { float oa[8], ob[8], tp[10];
#pragma unroll
              for (int i = 0; i < 5; ++i) { const f32x2 tt = *(const LAS f32x2*)(s_tp + i * 512 + j * 64 + 2 * cp); tp[i] = tt[0]; tp[5 + i] = tt[1]; }
#pragma unroll
              for (int i = 0; i < 8; ++i) { const float r0 = __builtin_bit_cast(float, xr[i] << 16), r1 = __builtin_bit_cast(float, xr[i + 1] << 16), r2 = __builtin_bit_cast(float, xr[i + 2] << 16), r3 = __builtin_bit_cast(float, xr[i + 3] << 16);
                  const float q0 = __builtin_bit_cast(float, xr[i] & 0xffff0000u), q1 = __builtin_bit_cast(float, xr[i + 1] & 0xffff0000u), q2 = __builtin_bit_cast(float, xr[i + 2] & 0xffff0000u), q3 = __builtin_bit_cast(float, xr[i + 3] & 0xffff0000u);
                  oa[i] = fsilu(tp[4] + tp[0] * r0 + tp[1] * r1 + tp[2] * r2 + tp[3] * r3); ob[i] = fsilu(tp[9] + tp[5] * q0 + tp[6] * q1 + tp[7] * q2 + tp[8] * q3); }
              const LAS float* sc = s_dt + j * 128 + l0; const f32x4 s0 = *(const LAS f32x4*)sc, s1 = *(const LAS f32x4*)(sc + 4);
#pragma unroll
              for (int i = 0; i < 4; ++i) { oa[i] *= s0[i]; ob[i] *= s0[i]; oa[4 + i] *= s1[i]; ob[4 + i] *= s1[i]; }
              v4u wa, wb; wa.x = cvtpk(oa[0], oa[1]); wa.y = cvtpk(oa[2], oa[3]); wa.z = cvtpk(oa[4], oa[5]); wa.w = cvtpk(oa[6], oa[7]);
              wb.x = cvtpk(ob[0], ob[1]); wb.y = cvtpk(ob[2], ob[3]); wb.z = cvtpk(ob[4], ob[5]); wb.w = cvtpk(ob[6], ob[7]);
              *(LAS v4u*)(XT + (2 * cp) * PITCH + l0 * 2) = wa; *(LAS v4u*)(XT + (2 * cp + 1) * PITCH + l0 * 2) = wb; }
#pragma unroll
            for (int it = 0; it < 2; ++it) { const int idx = tid + it * NTHR; *(LAS v4u*)(PV + (idx >> 4) * PITCH + (idx & 15) * 16) = pvr[it]; }
            v2u zc[4];
#pragma unroll
            for (int pb = 0; pb < 4; ++pb) zc[pb] = zr[pb];
            const float al = s_acum[j * 128 + lrow], dsk = s_dk[j] / s_dt[j * 128 + lrow];
#pragma unroll
            for (int sb = 0; sb < 8; ++sb) { if (sb <= w) { f32x4 m;
                if (sb < w) { const float F = __expf(al - s_acum[j * 128 + 16 * sb + 15]); m = cb[sb] * F * *(const LAS f32x4*)(s_g + j * 128 + 16 * sb + 4 * q); }
                else { const f32x4 as = *(const LAS f32x4*)(s_acum + j * 128 + 16 * sb + 4 * q);
#pragma unroll
                    for (int i = 0; i < 4; ++i) { const int s = 16 * sb + 4 * q + i; float v = cb[sb][i] * __expf(al - as[i]); if (s > lrow) v = 0.f; if (s == lrow) v += dsk; m[i] = v; } }
                *(LAS v2u*)(MS + r * PITCH + (16 * sb + 4 * q) * 2) = pack4(m); } }
            if (j < 7) S3_LOADS(j + 1);
            __syncthreads();
            f32x4 yd[4], yo[4];
#pragma unroll
            for (int pb = 0; pb < 4; ++pb) { yd[pb] = zero4(); yo[pb] = zero4(); }
#pragma unroll
            for (int ks = 0; ks < 4; ++ks) {
                const bf16x8 cf = cfr[ks];
                bf16x8 pf[4];
#pragma unroll
                for (int pb = 0; pb < 4; ++pb) pf[pb] = *(const LAS bf16x8*)(PV + (16 * pb + r) * PITCH + (32 * ks + 8 * q) * 2);
#pragma unroll
                for (int pb = 0; pb < 4; ++pb) yo[pb] = mfma16(pf[pb], cf, yo[pb]);
                if (2 * ks <= w) { const bf16x8 mf = *(const LAS bf16x8*)(MS + r * PITCH + (32 * ks + 8 * q) * 2);
#pragma unroll
                    for (int pb = 0; pb < 4; ++pb) pf[pb] = *(const LAS bf16x8*)(XT + (16 * pb + r) * PITCH + (32 * ks + 8 * q) * 2);
#pragma unroll
                    for (int pb = 0; pb < 4; ++pb) yd[pb] = mfma16(pf[pb], mf, yd[pb]); }
            }
            const float ea = __expf(al);
            const size_t zoff = (size_t)(t0 + lrow) * DIN + hd * 64 + 4 * q;
#pragma unroll
            for (int pb = 0; pb < 4; ++pb) { const f32x4 y = (yd[pb] + ea * yo[pb]) * unpack4(zc[pb]); const f32x4 q2 = y * y; ss += (q2[0] + q2[1]) + (q2[2] + q2[3]);
                *(v2u*)(YB + zoff + 16 * pb) = pack4(y); }
        }
#undef S3_LOADS
        ss += __shfl_xor(ss, 16); ss += __shfl_xor(ss, 32);
        const float rinv = __builtin_amdgcn_rsqf(ss * (1.f / 512.f) + EPS);
        asm volatile("s_waitcnt vmcnt(0)" ::: "memory");
        { bf16* zb = YB + (size_t)(t0 + lrow) * DIN + g * 512 + 4 * q; const float* ngb = p->ssd_norm_g + g * 512 + 4 * q;
          v2u zv[2][4]; f32x4 gv[2][4];
#define S3_NLOAD(j_) do { _Pragma("unroll") for (int pb = 0; pb < 4; ++pb) { zv[(j_) & 1][pb] = *(const v2u*)(zb + (j_) * 64 + 16 * pb); gv[(j_) & 1][pb] = *(const f32x4*)(ngb + (j_) * 64 + 16 * pb); } } while (0)
          S3_NLOAD(0);
#pragma unroll
          for (int j = 0; j < 8; ++j) { if (j < 7) S3_NLOAD(j + 1);
#pragma unroll
              for (int pb = 0; pb < 4; ++pb) *(v2u*)(zb + j * 64 + 16 * pb) = pack4(unpack4(zv[j & 1][pb]) * rinv * gv[j & 1][pb]); }
#undef S3_NLOAD
        }
    }
}
}
constexpr int LDS_BYTES = 147456;
constexpr int NPH = 14;
#ifndef MK_ONE_LAUNCH
#define MK_ONE_LAUNCH 1
#endif
constexpr int CW_BAR = 4096;

__global__ void __launch_bounds__(NTHR, 2) k_run(P p_unused) {
    const KP p = (KP)__builtin_amdgcn_kernarg_segment_ptr();
    extern __shared__ __attribute__((aligned(16))) unsigned char lds[];
    volatile LAS unsigned* MISC = (volatile LAS unsigned*)(lds + LDS_BYTES - 64);
    if (threadIdx.x < 16) MISC[threadIdx.x] = 0u;
    __syncthreads();
    XcdBarrier bar; bar.bar = (unsigned*)(p->ws + WS_CTL) + CW_BAR; bar.x = 0; bar.st = nullptr;
    if (MK_ONE_LAUNCH) bar = xcd_barrier_post((unsigned*)(p->ws + WS_CTL) + CW_BAR, MISC + 8);
#define IN(k) (p->ph_lo <= (k) && (k) < p->ph_hi)
#define SEAM(k) do { if (MK_ONE_LAUNCH && IN(k) && IN((k) + 1)) xcd_barrier(bar); } while (0)
    LAS unsigned char* L = (LAS unsigned char*)lds;
    unsigned char* ws = p->ws;
    if (IN(0)) { mk::mod_phase(p, L); mk::rope_phase(p); __syncthreads(); mk::conv_wdt(p, L); mk::conv_router(p, L); mk::conv_mixer_weights(p, L); } SEAM(0);
    if (IN(1)) { mk::h_dt_phase(p, L); } SEAM(1);
    if (IN(2)) { mk::EpiSsdCols E{ws}; pg8::StaticOrder S; S.init(T, 5120, (int)gridDim.x, (int)blockIdx.x);
                 LAS int* tokl = (LAS int*)(L + mk::LM_OFF + 2048);
                 __syncthreads();
                 for (int i = 0; i < 8; ++i) { pg8::Unit u; if (!S.next(i, u)) break; if (threadIdx.x < 256) tokl[i * 256 + threadIdx.x] = u.pm * 256 + (int)threadIdx.x; }
                 __syncthreads();
                 pg8::Gemm g{(const bf16*)(ws + WS_H8), (const bf16*)(ws + WS_WTIN8), T, 5120, 512};
                 pg8::gemm_phase_gather<mk::EpiSsdCols, pg8::StaticOrder, true>(L, g, S, E, tokl); } SEAM(2);
    if (IN(3)) { ssd::states_phase(p, L); } SEAM(3);
    if (IN(4)) { ssd::scan_phase(p); }
    if (MK_ONE_LAUNCH) xcd_barrier_arrive(bar);
    if (IN(5)) { ssd::output_phase<MK_ONE_LAUNCH != 0>(p, L, bar); }
    if (MK_ONE_LAUNCH) { xcd_barrier_arrive(bar); if (threadIdx.x == 0) MISC[13] = 1u; }
    if (IN(6)) { mk::EpiAttCols E{ws, p->q_norm_g, p->k_norm_g, (const float*)(ws + WS_ROPE), 0.125f * 1.4426950408889634f, bar, MK_ONE_LAUNCH != 0, (volatile LAS unsigned*)(MISC + 13)};
                 mk::run_gemm(L, (const bf16*)(ws + WS_H), (const bf16*)(ws + WS_WTIN), 5120, 1024, E); } SEAM(6);
    if (IN(7)) { mk::attn_phase(p, lds); }
    if (MK_ONE_LAUNCH) { xcd_barrier_arrive(bar); if (threadIdx.x == 0) MISC[13] = 1u; }
    if (IN(8)) { mk::EpiGateB E1{(bf16*)(ws + WS_D), (const bf16*)(ws + WS_GB), bar, MK_ONE_LAUNCH != 0, (volatile LAS unsigned*)(MISC + 13)};
                 mk::run_gemm(L, (const bf16*)(ws + WS_YB), (const bf16*)(ws + WS_WTB), 1024, 2048, E1);
                 mk::EpiMergeA E2{(bf16*)(ws + WS_MG), (const bf16*)(ws + WS_GA), (const bf16*)(ws + WS_D)};
                 mk::run_gemm(L, (const bf16*)(ws + WS_H), (const bf16*)(ws + WS_WTA), 1024, 1024, E2); } SEAM(8);
    if (IN(9)) { mk::EpiMix E{p->out, p->x, (const float*)(ws + WS_MODV)};
                 mk::run_gemm(L, (const bf16*)(ws + WS_MG), (const bf16*)(ws + WS_WTOUT), 1024, 1024, E); }
    { const bool early = MK_ONE_LAUNCH && gridDim.x == 256;
      if (MK_ONE_LAUNCH) xcd_barrier_arrive(bar);
      if (early && IN(10)) mk::conv_expert_weights_q(p, L);
      if (MK_ONE_LAUNCH) xcd_barrier_wait(bar);
      if (IN(10)) { if (gridDim.x == 256) mk::route_phase3<true>(p, L); else mk::route_phase3<false>(p, L); if (!early) mk::conv_expert_weights_q(p, L); } } SEAM(10);
    if (IN(11)) { mk::moe_up_phase(p, L); }
    if (MK_ONE_LAUNCH) xcd_barrier_arrive(bar);
    if (IN(12)) { mk::moe_down_phase<MK_ONE_LAUNCH != 0>(p, L, bar); } SEAM(12);
    if (IN(13)) { mk::final_phase(p); }
#undef IN
#undef SEAM
}

extern "C" void kernel_launch(void* const* d_in, const int* in_sizes, int n_in, void* d_out, int out_size, void* d_ws, size_t ws_size, hipStream_t stream) {
    static int grid = 0;
    if (grid == 0) {
        if (n_in != 29 || out_size != T * DM || ws_size < WS_END) { fprintf(stderr, "kernel_launch: unexpected shapes (n_in %d out %d ws %zu)\n", n_in, out_size, ws_size); grid = -1; return; }
        int dev = 0, cus = 0;
        if (hipGetDevice(&dev) != hipSuccess || hipDeviceGetAttribute(&cus, hipDeviceAttributeMultiprocessorCount, dev) != hipSuccess) { grid = -1; return; }
        if (hipFuncSetAttribute((const void*)k_run, hipFuncAttributeMaxDynamicSharedMemorySize, LDS_BYTES) != hipSuccess) { grid = -1; return; }
        (void)hipGetLastError();
        grid = cus;
    }
    if (grid < 0) return;
    (void)hipMemsetAsync((char*)d_ws + WS_CTL, 0, CTL_ZERO_BYTES, stream);
    P p{};
    const void** pp = (const void**)&p;
    for (int i = 0; i < 29; ++i) pp[i] = d_in[i];
    p.out = (float*)d_out; p.ws = (unsigned char*)d_ws;
    if (MK_ONE_LAUNCH) { p.ph_lo = 0; p.ph_hi = NPH; hipLaunchKernelGGL(k_run, dim3(grid), dim3(NTHR), LDS_BYTES, stream, p); }
    else for (int k = 0; k < NPH; ++k) { p.ph_lo = k; p.ph_hi = k + 1; hipLaunchKernelGGL(k_run, dim3(grid), dim3(NTHR), LDS_BYTES, stream, p); }
}
```

```cpp
#include <hip/hip_runtime.h>
#include <cstdint>
#include <cstdio>

#define LAS __attribute__((address_space(3)))
#define GAS __attribute__((address_space(1)))
typedef unsigned short bf16;
typedef unsigned v4u __attribute__((ext_vector_type(4)));
typedef unsigned v2u __attribute__((ext_vector_type(2)));
typedef float f32x4 __attribute__((ext_vector_type(4)));
typedef float f32x2 __attribute__((ext_vector_type(2)));
typedef float f32x16 __attribute__((ext_vector_type(16)));
typedef short bf16x8 __attribute__((ext_vector_type(8)));
typedef short s16x4 __attribute__((ext_vector_type(4)));

constexpr int BATCH = 2, SEQ = 8192, DM = 1024, T = BATCH * SEQ;
constexpr int INW = 10272;
constexpr int C_Q = 0, C_K = 1024, C_V = 2048, C_GA = 3072, C_GB = 4096, C_Z = 5120, C_XBC = 7168, C_DT = 10240;
constexpr int NHEAD = 8, HD = 64, VD = 128;
constexpr int SSD_H = 32, SSD_P = 64, SSD_G = 4, SSD_N = 128, SSD_L = 128, SSD_NC = SEQ / SSD_L, CONV_DIM = 3072, DIN = 2048;
constexpr int NEXP = 64, TOPK = 8, EDIM = 256;
constexpr float EPS = 1e-6f;
constexpr float LAMBDA_INIT = 0.2f;
constexpr float ROUTED_SCALE = 2.5f;
constexpr int NTHR = 512, NWAVE = 8;
constexpr float WGU_SCALE = 64.f, WD_SCALE = 32.f, ACT_SCALE = 8.f, WIN_SCALE = 64.f;
constexpr float YB_SCALE = 8.f, YA_SCALE = 8.f, WM_SCALE = 64.f;

constexpr size_t MiB = 1u << 20;
constexpr size_t WS_CTL = 0;
constexpr size_t CTL_ZERO_BYTES = 65536;
constexpr size_t WS_MODV = 1 * MiB;
constexpr size_t WS_DTP = 2 * MiB;
constexpr size_t WS_ROPE = 4 * MiB;
constexpr size_t WS_CD = 8 * MiB;
constexpr size_t WS_PAIRW = 9 * MiB;
constexpr size_t WS_PAIRE = 9 * MiB + 512 * 1024;
constexpr size_t WS_LISTS = 10 * MiB;
constexpr size_t WS_WTA = 14 * MiB, WS_WTB = 16 * MiB, WS_WTOUT = 20 * MiB, WS_WTDT = 22 * MiB;
constexpr size_t WS_H = 24 * MiB;
constexpr size_t WS_A = 56 * MiB;
constexpr size_t WS_B = 120 * MiB;
constexpr size_t WS_C = 216 * MiB;
constexpr size_t WS_D = 280 * MiB;
constexpr size_t WS_WTIN = 312 * MiB;
constexpr size_t WS_END = 332 * MiB;
constexpr size_t WS_H8 = 280 * MiB, WS_WTIN8 = 296 * MiB;
constexpr size_t WS_WTIN8VG = WS_WTIN + 4 * MiB;
constexpr size_t WS_SH = 297 * MiB;
constexpr size_t WS_Q = WS_B, WS_K = WS_B + 32 * MiB, WS_V = WS_B + 64 * MiB;
constexpr size_t WS_GA = WS_A, WS_GB = WS_A + 32 * MiB;
constexpr size_t WS_YB = WS_C;
constexpr size_t WS_YB8 = WS_H;
constexpr size_t WS_YA8 = WS_C;
constexpr size_t WS_MG = 120 * MiB;
constexpr size_t WS_MIX = WS_H;
constexpr size_t WS_ACT = 56 * MiB;
constexpr size_t WS_WTD = 136 * MiB;
constexpr size_t WS_WTGU = 169 * MiB;
constexpr size_t WS_H2 = 234 * MiB;
constexpr size_t WS_Y = 169 * MiB;
constexpr size_t WS_LW = 4 * MiB;

__device__ __forceinline__ unsigned f2bf(float f) { unsigned u = __builtin_bit_cast(unsigned, f); return (u + 0x7fffu + ((u >> 16) & 1u)) >> 16; }
__device__ __forceinline__ float bf2f(unsigned h) { return __builtin_bit_cast(float, (h & 0xffffu) << 16); }
__device__ __forceinline__ unsigned pk2(float lo, float hi) { return f2bf(lo) | (f2bf(hi) << 16); }
__device__ __forceinline__ float sigmoidf_(float x) { return 1.f / (1.f + __expf(-x)); }
__device__ __forceinline__ float siluf_(float x) { return x / (1.f + __expf(-x)); }
__device__ __forceinline__ float softplusf_(float x) { return x > 20.f ? x : log1pf(__expf(x)); }
__device__ __forceinline__ float wave_sum(float v) {
#pragma unroll
    for (int o = 1; o < 64; o <<= 1) v += __shfl_xor(v, o);
    return v;
}
__device__ __forceinline__ float block_sum(float v, LAS float* red) {
    v = wave_sum(v);
    __syncthreads();
    if ((threadIdx.x & 63) == 0) red[threadIdx.x >> 6] = v;
    __syncthreads();
    float s = 0.f;
#pragma unroll
    for (int i = 0; i < NWAVE; ++i) s += red[i];
    return s;
}

struct P;
typedef const __attribute__((address_space(4))) P* KP;
struct P {
    const float* x; const float* c; const int* positions; const float* w_ada; const float* b_ada; const float* norm1_g; const float* w_in;
    const float* q_norm_g; const float* k_norm_g; const float* lambda_qk; const float* subln_g; const float* conv_w; const float* conv_b;
    const float* dt_bias; const float* a_log; const float* d_skip; const float* ssd_norm_g; const float* w_branch_a; const float* w_branch_b;
    const float* w_out; const float* norm2_g; const float* w_router; const float* router_bias; const float* w_exp_gate; const float* w_exp_up;
    const float* w_exp_down; const float* w_sh_gate; const float* w_sh_up; const float* w_sh_down;
    float* out; unsigned char* ws; int ph_lo, ph_hi;
};
#define XB_TMO      128
#define XB_XCNT(j)  (256  + 64 * (j))
#define XB_XSUB(j)  (1280 + 64 * (j))
#define XB_XGEN(j)  (2304 + 64 * (j))
#define XB_TOP      3328
#define XB_TOPGEN   3392
#define XCD_BAR_WORDS 3456
#define XB_SPIN_CAP (1u << 23)

__device__ __forceinline__ unsigned xb_ld(unsigned* p)              { return __hip_atomic_load(p, __ATOMIC_RELAXED, __HIP_MEMORY_SCOPE_AGENT); }
__device__ __forceinline__ unsigned xb_add(unsigned* p, unsigned v) { return __hip_atomic_fetch_add(p, v, __ATOMIC_RELAXED, __HIP_MEMORY_SCOPE_AGENT); }
__device__ __forceinline__ unsigned xb_xcc_id() { return (unsigned)__builtin_amdgcn_s_getreg((3 << 11) | 20) & 0xFu; }
#define XB_SPIN(cond, bar) do { unsigned _sp = 0; while (cond) { __builtin_amdgcn_s_sleep(1); \
    if ((++_sp & 255u) == 0u) { if (xb_ld(&(bar)[XB_TMO])) break; if (_sp > XB_SPIN_CAP) { atomicAdd(&(bar)[XB_TMO], 1u); break; } } } } while (0)

struct XcdBarrier {
    unsigned* bar; unsigned x;
    volatile LAS unsigned* st;
};

__device__ __forceinline__ XcdBarrier xcd_barrier_post(unsigned* bar, volatile LAS unsigned* st) {
    XcdBarrier b; b.bar = bar; b.x = xb_xcc_id(); b.st = st;
    if (threadIdx.x == 0) (void)xb_add(&bar[XB_XCNT(b.x)], 1u);
    return b;
}
__device__ __forceinline__ void xcd_barrier_complete(unsigned* bar, unsigned x, unsigned& nloc, unsigned& nx) {
    const unsigned G = gridDim.x * gridDim.y * gridDim.z;
    unsigned sum, cnt, mine, sp = 0u;
    for (;;) {
        sum = 0u; cnt = 0u; mine = 0u;
#pragma unroll
        for (unsigned j = 0; j < 16; ++j) { const unsigned c = xb_ld(&bar[XB_XCNT(j)]); sum += c; cnt += (c > 0u) ? 1u : 0u; mine = (j == x) ? c : mine; }
        if (sum == G) break;
        __builtin_amdgcn_s_sleep(1);
        if ((++sp & 255u) == 0u) { if (xb_ld(&bar[XB_TMO])) break; if (sp > XB_SPIN_CAP) { atomicAdd(&bar[XB_TMO], 1u); break; } }
    }
    nloc = mine > 0u ? mine : 1u; nx = cnt > 0u ? cnt : 1u;
}

__device__ __forceinline__ void xcd_barrier(const XcdBarrier& b) {
    asm volatile("s_waitcnt vmcnt(0)" ::: "memory");
    __syncthreads();
    if (threadIdx.x == 0) {
        unsigned* bar = b.bar;
        __builtin_amdgcn_s_waitcnt(0);
        unsigned nloc = b.st[0], nx = b.st[1];
        if (nloc == 0u) { xcd_barrier_complete(bar, b.x, nloc, nx); b.st[0] = nloc; b.st[1] = nx; }
        const unsigned old = xb_add(&bar[XB_XSUB(b.x)], 1u);
        const unsigned gen = old / nloc;
        if (old + 1u == (gen + 1u) * nloc) {
            __builtin_amdgcn_fence(__ATOMIC_RELEASE, "agent");
            asm volatile("s_waitcnt vmcnt(0)" ::: "memory");
            const unsigned og = xb_add(&bar[XB_TOP], 1u);
            const unsigned tg = og / nx;
            if (og + 1u == (tg + 1u) * nx) xb_add(&bar[XB_TOPGEN], 1u);
            else XB_SPIN(xb_ld(&bar[XB_TOPGEN]) == tg, bar);
            __builtin_amdgcn_fence(__ATOMIC_ACQUIRE, "agent");
            xb_add(&bar[XB_XGEN(b.x)], 1u);
            asm volatile("s_waitcnt vmcnt(0)" ::: "memory");
        } else {
            XB_SPIN(xb_ld(&bar[XB_XGEN(b.x)]) == gen, bar);
            __builtin_amdgcn_fence(__ATOMIC_ACQUIRE, "agent");
            asm volatile("s_waitcnt vmcnt(0)" ::: "memory");
        }
    }
    __syncthreads();
}

__device__ __forceinline__ void xcd_barrier_arrive(const XcdBarrier& b) {
    struct { unsigned gen, tg; int role; } t; t.gen = 0u; t.tg = 0u; t.role = 0;
    asm volatile("s_waitcnt vmcnt(0)" ::: "memory");
    __syncthreads();
    if (threadIdx.x == 0) {
        unsigned* bar = b.bar;
        __builtin_amdgcn_s_waitcnt(0);
        unsigned nloc = b.st[0], nx = b.st[1];
        if (nloc == 0u) { xcd_barrier_complete(bar, b.x, nloc, nx); b.st[0] = nloc; b.st[1] = nx; }
        const unsigned old = xb_add(&bar[XB_XSUB(b.x)], 1u);
        t.gen = old / nloc;
        if (old + 1u == (t.gen + 1u) * nloc) {
            __builtin_amdgcn_fence(__ATOMIC_RELEASE, "agent");
            asm volatile("s_waitcnt vmcnt(0)" ::: "memory");
            const unsigned og = xb_add(&bar[XB_TOP], 1u);
            t.tg = og / nx;
            if (og + 1u == (t.tg + 1u) * nx) { xb_add(&bar[XB_TOPGEN], 1u); t.role = 2; } else t.role = 1;
        }
        b.st[2] = t.gen; b.st[3] = t.tg; b.st[4] = (unsigned)t.role;
    }
}
__device__ __forceinline__ void xcd_barrier_wait(const XcdBarrier& b) {
    if (threadIdx.x == 0) {
        unsigned* bar = b.bar;
        struct { unsigned gen, tg; int role; } t; t.gen = b.st[2]; t.tg = b.st[3]; t.role = (int)b.st[4];
        if (t.role != 0) {
            if (t.role == 1) XB_SPIN(xb_ld(&bar[XB_TOPGEN]) == t.tg, bar);
            __builtin_amdgcn_fence(__ATOMIC_ACQUIRE, "agent");
            xb_add(&bar[XB_XGEN(b.x)], 1u);
            asm volatile("s_waitcnt vmcnt(0)" ::: "memory");
        } else {
            XB_SPIN(xb_ld(&bar[XB_XGEN(b.x)]) == t.gen, bar);
            __builtin_amdgcn_fence(__ATOMIC_ACQUIRE, "agent");
            asm volatile("s_waitcnt vmcnt(0)" ::: "memory");
        }
    }
    __syncthreads();
}

namespace pg8 {
#define PG8_LAS __attribute__((address_space(3)))
typedef unsigned short bf16_t;
typedef short bf16x8 __attribute__((ext_vector_type(8)));
typedef float f32x4 __attribute__((ext_vector_type(4)));
typedef unsigned u32x4 __attribute__((ext_vector_type(4)));
typedef int i32x4 __attribute__((ext_vector_type(4)));
constexpr int BM = 256, BK = 64, HALF = 128, HTB = HALF * BK * 2  , STAGE_BYTES = 8 * HTB, NXCD = 8, WGM = 8;

__host__ __device__ __forceinline__ int lds_byte(int r, int c) { const int st = (r >> 4) * 2 + (c >> 5), rr = r & 15, cc = c & 31, ob = rr * 64 + cc * 2; return st * 1024 + (ob ^ (((ob >> 9) & 1) << 5)); }
__host__ __device__ __forceinline__ void stage_rc(int b, int& R, int& C) { const int st = b / 1024, sb = b % 1024, swz = sb ^ (((sb >> 9) & 1) << 5); R = (st >> 1) * 16 + swz / 64; C = (st & 1) * 32 + (swz % 64) / 2; }
__host__ __device__ __forceinline__ int perm32(int rho) { const int n = rho >> 4, i = rho & 15; return 8 * (i >> 2) + 4 * n + (i & 3); }

struct Unit { int pm, pn; };
struct Gemm { const bf16_t* A; const bf16_t* Bt; int M, N, K; long dA = 0, dB = 0; int mid = 0x40000000, ntx = 0; };

struct StaticOrder {
    int nM, nN, nwg, G, c;
    __host__ __device__ __forceinline__ void init(int M, int N, int G_, int c_) { nM = M / BM; nN = N / BM; nwg = nM * nN; G = G_; c = c_; }
    __host__ __device__ __forceinline__ bool next(int i, Unit& u) const {
        const long L = (long)i * G + c; if (L >= nwg) return false;
        int wgid = (int)L; { const int q = nwg / NXCD, r = nwg % NXCD, xcd = wgid % NXCD, off = wgid / NXCD; wgid = (xcd < r ? xcd * (q + 1) : r * (q + 1) + (xcd - r) * q) + off; }
        const int nig = WGM * nN, gid = wgid / nig, fm = gid * WGM, gsz = (nM - fm) < WGM ? (nM - fm) : WGM;
        u.pm = fm + ((wgid % nig) % gsz); u.pn = (wgid % nig) / gsz; return true;
    }
    __device__ __forceinline__ void a_ready(const Unit&) const {}
    __device__ __forceinline__ void done(const Unit&) const {}
};

__device__ __forceinline__ unsigned cvt_pk_bf16(float lo, float hi) { unsigned r; asm volatile("v_cvt_pk_bf16_f32 %0, %1, %2" : "=v"(r) : "v"(lo), "v"(hi)); return r; }
typedef float f32x2 __attribute__((ext_vector_type(2)));
__device__ __forceinline__ f32x2 gelu_pk(f32x2 v) {
    const f32x2 av = __builtin_elementwise_abs(v), d = av * 0.2316418882f + 1.0f;
    f32x2 t; t.x = __builtin_amdgcn_rcpf(d.x); t.y = __builtin_amdgcn_rcpf(d.y);
    f32x2 q = t * 0.5307027145f + (-0.7265760135f); q = q * t + 0.7107068705f; q = q * t + (-0.142248368f); q = q * t + 0.127414796f; q = q * t;
    const f32x2 s = (v * v) * (-0.72134752044f);
    f32x2 e; e.x = __builtin_amdgcn_exp2f(s.x); e.y = __builtin_amdgcn_exp2f(s.y);
    const f32x2 m = v * (q * e), r = v - m;
    f32x2 o; o.x = v.x < 0.f ? m.x : r.x; o.y = v.y < 0.f ? m.y : r.y; return o;
}

template <int ACT  > struct EpiBf16 {
    static constexpr bool PERM = true, AFTER_DRAIN = false; static_assert(ACT == 0 || ACT == 1, "EpiBf16: ACT is 0 (none) or 1 (gelu_pk)");
    bf16_t* O; int ldc; const float* bias; int split_cols; size_t split_stride; float scale0;
    __device__ __forceinline__ void operator()(const f32x4 (&acc)[2][2][4][2], const Unit& u, int wr, int wc, int fr, int fq) const {
        const int row0 = u.pm * BM + wr * 64 + fr; int colt = u.pn * BM; bf16_t* base = O;
        float sc = 1.f; if (split_cols) { const int t = colt / split_cols; base += (size_t)t * split_stride; colt -= t * split_cols; if (t == 0) sc = scale0; }
        const int col0 = colt + wc * 32 + 8 * fq, bcol0 = u.pn * BM + wc * 32 + 8 * fq;
        f32x4 bv[2][2];
#pragma unroll
        for (int bj = 0; bj < 2; ++bj)
#pragma unroll
            for (int n = 0; n < 2; ++n) bv[bj][n] = bias ? *(const f32x4*)(bias + bcol0 + bj * HALF + 4 * n) : (f32x4){0.f, 0.f, 0.f, 0.f};
#pragma unroll
        for (int ai = 0; ai < 2; ++ai)
#pragma unroll
            for (int m = 0; m < 4; ++m) { bf16_t* rowp = base + (size_t)(row0 + ai * HALF + m * 16) * ldc + col0;
#pragma unroll
                for (int bj = 0; bj < 2; ++bj) { f32x4 v0 = acc[ai][bj][m][0] + bv[bj][0], v1 = acc[ai][bj][m][1] + bv[bj][1];
                    if (ACT == 1) { f32x2 a = gelu_pk((f32x2){v0[0], v0[1]}), b = gelu_pk((f32x2){v0[2], v0[3]}), c = gelu_pk((f32x2){v1[0], v1[1]}), d = gelu_pk((f32x2){v1[2], v1[3]});
                        v0 = (f32x4){a.x, a.y, b.x, b.y}; v1 = (f32x4){c.x, c.y, d.x, d.y}; }
                    v0 = v0 * sc; v1 = v1 * sc; u32x4 w; w.x = cvt_pk_bf16(v0[0], v0[1]); w.y = cvt_pk_bf16(v0[2], v0[3]); w.z = cvt_pk_bf16(v1[0], v1[1]); w.w = cvt_pk_bf16(v1[2], v1[3]);
                    *(u32x4*)(rowp + bj * HALF) = w; } }
    }
};
template <class Epi, class Sched, bool ALIGN_EPI = false, bool SP2 = false, bool FP8 = false>
__device__ __forceinline__ void gemm_phase(PG8_LAS unsigned char* lds, const Gemm g, const Sched& S, const Epi& E) {
    const int tid = threadIdx.x, wid = __builtin_amdgcn_readfirstlane(tid >> 6), lane = tid & 63, wr = wid >> 2, wc = wid & 3, fr = lane & 15, fq = lane >> 4;
    const int K = g.K, nt = K / BK;
    unsigned voffA[2], voffB[2];
#pragma unroll
    for (int i = 0; i < 2; ++i) { int R, C; stage_rc(tid * 16 + i * 8192, R, C); const int Rb = Epi::PERM ? ((R & ~31) + perm32(R & 31)) : R;
        voffA[i] = (unsigned)(R * K + C) * 2u; voffB[i] = (unsigned)(Rb * K + C) * 2u; }
    const size_t kstep = (size_t)(BK * 2);
    const size_t hstep = (size_t)HALF * K * 2;
    const size_t tstep = 2 * hstep;
    const unsigned ldsw = (unsigned)wid * 1024u;
    const int aoff = lds_byte(wr * 64 + fr, fq * 8), boff = lds_byte(wc * 32 + fr, fq * 8);
#define PG8_SA(b, h) (((b) * 2 + (h)) * HTB)
#define PG8_SB(b, h) ((4 + (b) * 2 + (h)) * HTB)
#define PG8_STAGE(bufoff, gbase, voff) do { _Pragma("unroll") for (int _i = 0; _i < 2; ++_i) \
        __builtin_amdgcn_global_load_lds((const unsigned*)((const char*)(gbase) + (voff)[_i]), (PG8_LAS unsigned*)(lds + (bufoff) + ldsw + _i * 8192), 16, 0, 0); } while (0)
#define PG8_LDA(dst, b, h) do { _Pragma("unroll") for (int m = 0; m < 4; ++m) _Pragma("unroll") for (int k = 0; k < 2; ++k) dst[m][k] = *(const PG8_LAS bf16x8*)(lds + PG8_SA(b, h) + aoff + m * 2048 + k * 1024); } while (0)
#define PG8_LDB(dst, b, h) do { _Pragma("unroll") for (int n = 0; n < 2; ++n) _Pragma("unroll") for (int k = 0; k < 2; ++k) dst[n][k] = *(const PG8_LAS bf16x8*)(lds + PG8_SB(b, h) + boff + n * 2048 + k * 1024); } while (0)
#define PG8_CAT(x, y) __builtin_shufflevector(__builtin_bit_cast(i32x4, x), __builtin_bit_cast(i32x4, y), 0, 1, 2, 3, 4, 5, 6, 7)
#define PG8_MMA(ai, bj, At, Bt) do { __builtin_amdgcn_s_setprio(1); \
        if constexpr (FP8) { _Pragma("unroll") for (int m = 0; m < 4; ++m) _Pragma("unroll") for (int n = 0; n < 2; ++n) \
            acc[ai][bj][m][n] = __builtin_amdgcn_mfma_scale_f32_16x16x128_f8f6f4(PG8_CAT(Bt[n][0], Bt[n][1]), PG8_CAT(At[m][0], At[m][1]), acc[ai][bj][m][n], 0, 0, 0, 0x7f7f7f7f, 0, 0x7f7f7f7f); } \
        else { _Pragma("unroll") for (int m = 0; m < 4; ++m) _Pragma("unroll") for (int n = 0; n < 2; ++n) _Pragma("unroll") for (int k = 0; k < 2; ++k) \
            acc[ai][bj][m][n] = __builtin_amdgcn_mfma_f32_16x16x32_bf16(Bt[n][k], At[m][k], acc[ai][bj][m][n], 0, 0, 0); } \
        __builtin_amdgcn_s_setprio(0); } while (0)
#define PG8_WAIT_V(n) asm volatile("s_waitcnt vmcnt(" #n ")" ::: "memory")
#define PG8_WAIT_L(n) asm volatile("s_waitcnt lgkmcnt(" #n ")" ::: "memory")
#define PG8_BAR __builtin_amdgcn_s_barrier()
#define PG8_SCHED __builtin_amdgcn_sched_barrier(0)
    Unit cur, nxt; int ui = 0;
    if (!S.next(0, cur)) return;
    f32x4 acc[2][2][4][2];
#pragma unroll
    for (int a = 0; a < 2; ++a)
#pragma unroll
        for (int b = 0; b < 2; ++b)
#pragma unroll
            for (int m = 0; m < 4; ++m)
#pragma unroll
                for (int n = 0; n < 2; ++n) acc[a][b][m][n] = (f32x4){0.f, 0.f, 0.f, 0.f};
    bf16x8 At[4][2], B0[2][2], B1[2][2];
    const char* cA = (const char*)g.A + (size_t)cur.pm * tstep; const char* cB = (const char*)g.Bt + (size_t)cur.pn * tstep;
    S.a_ready(cur);
    if constexpr (SP2) {
        PG8_STAGE(PG8_SB(0, 0), cB, voffB); PG8_STAGE(PG8_SB(0, 1), cB + hstep, voffB); PG8_STAGE(PG8_SA(0, 0), cA, voffA); PG8_STAGE(PG8_SA(0, 1), cA + hstep, voffA);
        if (wr == 1) PG8_BAR;
        PG8_WAIT_V(2); PG8_BAR;
        PG8_STAGE(PG8_SB(1, 0), cB + kstep, voffB); PG8_STAGE(PG8_SA(1, 0), cA + kstep, voffA); PG8_STAGE(PG8_SB(1, 1), cB + hstep + kstep, voffB);
        PG8_WAIT_V(6); PG8_BAR;
    } else {
        PG8_STAGE(PG8_SB(0, 0), cB, voffB); PG8_STAGE(PG8_SA(0, 0), cA, voffA); PG8_STAGE(PG8_SB(0, 1), cB + hstep, voffB); PG8_STAGE(PG8_SA(0, 1), cA + hstep, voffA);
        if (wr == 1) PG8_BAR;
        PG8_WAIT_V(4); PG8_BAR;
        PG8_STAGE(PG8_SB(1, 0), cB + kstep, voffB); PG8_STAGE(PG8_SA(1, 0), cA + kstep, voffA); PG8_STAGE(PG8_SB(1, 1), cB + hstep + kstep, voffB);
        PG8_WAIT_V(6); PG8_BAR;
    }
    for (;;) {
        const bool has_next = S.next(ui + 1, nxt);
        const char* nA = has_next ? (const char*)g.A + (size_t)nxt.pm * tstep : cA; const char* nB = has_next ? (const char*)g.Bt + (size_t)nxt.pn * tstep : cB;
#pragma unroll 1
        for (int t = 0; t < nt; t += 2) {
            const bool last = (t == nt - 2);
            const char* a1 = cA + (size_t)(t + 1) * kstep;
            const char* a2 = last ? nA : cA + (size_t)(t + 2) * kstep; const char* b2 = last ? nB : cB + (size_t)(t + 2) * kstep;
            const char* a3 = a2 + kstep; const char* b3 = b2 + kstep;
            if (last && has_next) S.a_ready(nxt);
            if constexpr (SP2) {
            PG8_LDB(B0, 0, 0); PG8_LDB(B1, 0, 1); PG8_SCHED; PG8_LDA(At, 0, 0); PG8_STAGE(PG8_SA(1, 1), a1 + hstep, voffA);
            PG8_WAIT_V(8); PG8_WAIT_L(0); PG8_BAR; PG8_MMA(0, 0, At, B0); PG8_MMA(0, 1, At, B1); PG8_BAR; PG8_SCHED;
            PG8_LDA(At, 0, 1); PG8_STAGE(PG8_SB(0, 0), b2, voffB); PG8_STAGE(PG8_SB(0, 1), b2 + hstep, voffB); PG8_STAGE(PG8_SA(0, 0), a2, voffA);
            PG8_WAIT_V(8); PG8_WAIT_L(0); PG8_BAR; PG8_MMA(1, 0, At, B0); PG8_MMA(1, 1, At, B1); PG8_BAR; PG8_SCHED;
            PG8_LDB(B0, 1, 0); PG8_LDB(B1, 1, 1); PG8_SCHED; PG8_LDA(At, 1, 0); PG8_STAGE(PG8_SA(0, 1), a2 + hstep, voffA);
            PG8_WAIT_V(8); PG8_WAIT_L(0); PG8_BAR; PG8_MMA(0, 0, At, B0); PG8_MMA(0, 1, At, B1); PG8_BAR; PG8_SCHED;
            PG8_LDA(At, 1, 1); PG8_STAGE(PG8_SB(1, 0), b3, voffB); PG8_STAGE(PG8_SB(1, 1), b3 + hstep, voffB); PG8_STAGE(PG8_SA(1, 0), a3, voffA);
            PG8_WAIT_V(8); PG8_WAIT_L(0); PG8_BAR; PG8_MMA(1, 0, At, B0); PG8_MMA(1, 1, At, B1); PG8_BAR; PG8_SCHED;
            } else {
            PG8_LDB(B0, 0, 0); PG8_SCHED; PG8_LDA(At, 0, 0); PG8_STAGE(PG8_SA(1, 1), a1 + hstep, voffA);
            PG8_WAIT_L(8); PG8_BAR; PG8_WAIT_L(0); PG8_MMA(0, 0, At, B0); PG8_BAR; PG8_SCHED;
            PG8_LDB(B1, 0, 1); PG8_STAGE(PG8_SB(0, 0), b2, voffB);
            PG8_BAR; PG8_WAIT_L(0); PG8_MMA(0, 1, At, B1); PG8_BAR;
            PG8_LDA(At, 0, 1); PG8_STAGE(PG8_SA(0, 0), a2, voffA);
            PG8_BAR; PG8_WAIT_L(0); PG8_MMA(1, 0, At, B0); PG8_BAR; PG8_SCHED;
            PG8_STAGE(PG8_SB(0, 1), b2 + hstep, voffB);
            PG8_WAIT_V(6); PG8_BAR; PG8_MMA(1, 1, At, B1); PG8_BAR;
            PG8_LDB(B0, 1, 0); PG8_SCHED; PG8_LDA(At, 1, 0); PG8_STAGE(PG8_SA(0, 1), a2 + hstep, voffA);
            PG8_WAIT_L(8); PG8_BAR; PG8_WAIT_L(0); PG8_MMA(0, 0, At, B0); PG8_BAR; PG8_SCHED;
            PG8_LDB(B1, 1, 1); PG8_STAGE(PG8_SB(1, 0), b3, voffB);
            PG8_BAR; PG8_WAIT_L(0); PG8_MMA(0, 1, At, B1); PG8_BAR;
            PG8_LDA(At, 1, 1); PG8_STAGE(PG8_SA(1, 0), a3, voffA);
            PG8_BAR; PG8_WAIT_L(0); PG8_MMA(1, 0, At, B0); PG8_BAR; PG8_SCHED;
            PG8_STAGE(PG8_SB(1, 1), b3 + hstep, voffB);
            PG8_WAIT_V(6); PG8_BAR; PG8_MMA(1, 1, At, B1); PG8_BAR;
            }
        }
        if constexpr (ALIGN_EPI) { if (wr == 0) PG8_BAR; }
        if constexpr (!Epi::AFTER_DRAIN) { E(acc, cur, wr, wc, fr, fq); S.done(cur); }
        if (!has_next) break;
#pragma unroll
        for (int a = 0; a < 2; ++a)
#pragma unroll
            for (int b = 0; b < 2; ++b)
#pragma unroll
                for (int m = 0; m < 4; ++m)
#pragma unroll
                    for (int n = 0; n < 2; ++n) acc[a][b][m][n] = (f32x4){0.f, 0.f, 0.f, 0.f};
        cur = nxt; cA = nA; cB = nB; ++ui;
        if constexpr (ALIGN_EPI) { if (wr == 1) PG8_BAR; }
    }
    PG8_WAIT_V(0);
    if constexpr (!ALIGN_EPI) { if (wr == 0) PG8_BAR; }
    PG8_BAR;
    if constexpr (Epi::AFTER_DRAIN) { E.fused(acc, cur, wr, wc, fr, fq, lds, wid, lane); S.done(cur); }
#undef PG8_SA
#undef PG8_SB
#undef PG8_STAGE
#undef PG8_LDA
#undef PG8_LDB
#undef PG8_MMA
#undef PG8_CAT
#undef PG8_WAIT_V
#undef PG8_WAIT_L
#undef PG8_BAR
#undef PG8_SCHED
}
}
namespace pg8 {
template <class Epi, class Sched, bool FP8 = false, bool IDENT = false, bool MID = false>
__device__ __forceinline__ void gemm_phase_gather(PG8_LAS unsigned char* lds, const Gemm g, const Sched& S, const Epi& E, const PG8_LAS int* tokl) {
    constexpr bool ALIGN_EPI = true, SP2 = true;
    int tid_ = threadIdx.x; asm volatile("" : "+v"(tid_));
    const int tid = tid_, wid = __builtin_amdgcn_readfirstlane(tid >> 6), lane = tid & 63, wr = wid >> 2, wc = wid & 3, fr = lane & 15, fq = lane >> 4;
    const int K = g.K, nt = g.ntx ? g.ntx : K / BK;
    const int mid = g.mid; const long dA = g.dA, dB = g.dB;
    unsigned voffB[2];
#pragma unroll
    for (int i = 0; i < 2; ++i) { int R, C; stage_rc(tid * 16 + i * 8192, R, C); const int Rb = Epi::PERM ? ((R & ~31) + perm32(R & 31)) : R;
        voffB[i] = (unsigned)(Rb * K + C) * 2u; }
    unsigned va0[2], va1[2]; const unsigned voffA[2] = {0u, 0u};
#define PG8_VOFF(un_, ui_, d0, d1) do { _Pragma("unroll") for (int _i = 0; _i < 2; ++_i) { int R_, C_; stage_rc(tid * 16 + _i * 8192, R_, C_); \
        const int t0_ = IDENT ? (un_).pm * 256 + R_ : tokl[(ui_) * 256 + R_], t1_ = IDENT ? (un_).pm * 256 + 128 + R_ : tokl[(ui_) * 256 + 128 + R_]; \
        d0[_i] = (unsigned)(t0_ * K + C_) * 2u; d1[_i] = (unsigned)(t1_ * K + C_) * 2u; } } while (0)
    const size_t kstep = (size_t)(BK * 2);
    const size_t hstep = (size_t)HALF * K * 2;
    const size_t tstep = 2 * hstep;
    const unsigned ldsw = (unsigned)wid * 1024u;
    const int aoff = lds_byte(wr * 64 + fr, fq * 8), boff = lds_byte(wc * 32 + fr, fq * 8);
#define PG8_SA(b, h) (((b) * 2 + (h)) * HTB)
#define PG8_SB(b, h) ((4 + (b) * 2 + (h)) * HTB)
#define PG8_STAGE(bufoff, gbase, voff) do { _Pragma("unroll") for (int _i = 0; _i < 2; ++_i) \
        __builtin_amdgcn_global_load_lds((const unsigned*)((const char*)(gbase) + (voff)[_i]), (PG8_LAS unsigned*)(lds + (bufoff) + ldsw + _i * 8192), 16, 0, 0); } while (0)
#define PG8_LDA(dst, b, h) do { _Pragma("unroll") for (int m = 0; m < 4; ++m) _Pragma("unroll") for (int k = 0; k < 2; ++k) dst[m][k] = *(const PG8_LAS bf16x8*)(lds + PG8_SA(b, h) + aoff + m * 2048 + k * 1024); } while (0)
#define PG8_LDB(dst, b, h) do { _Pragma("unroll") for (int n = 0; n < 2; ++n) _Pragma("unroll") for (int k = 0; k < 2; ++k) dst[n][k] = *(const PG8_LAS bf16x8*)(lds + PG8_SB(b, h) + boff + n * 2048 + k * 1024); } while (0)
#define PG8_CAT(x, y) __builtin_shufflevector(__builtin_bit_cast(i32x4, x), __builtin_bit_cast(i32x4, y), 0, 1, 2, 3, 4, 5, 6, 7)
#define PG8_MMA(ai, bj, At, Bt) do { __builtin_amdgcn_s_setprio(1); \
        if constexpr (FP8) { _Pragma("unroll") for (int m = 0; m < 4; ++m) _Pragma("unroll") for (int n = 0; n < 2; ++n) \
            acc[ai][bj][m][n] = __builtin_amdgcn_mfma_scale_f32_16x16x128_f8f6f4(PG8_CAT(Bt[n][0], Bt[n][1]), PG8_CAT(At[m][0], At[m][1]), acc[ai][bj][m][n], 0, 0, 0, 0x7f7f7f7f, 0, 0x7f7f7f7f); } \
        else { _Pragma("unroll") for (int m = 0; m < 4; ++m) _Pragma("unroll") for (int n = 0; n < 2; ++n) _Pragma("unroll") for (int k = 0; k < 2; ++k) \
            acc[ai][bj][m][n] = __builtin_amdgcn_mfma_f32_16x16x32_bf16(Bt[n][k], At[m][k], acc[ai][bj][m][n], 0, 0, 0); } \
        __builtin_amdgcn_s_setprio(0); } while (0)
#define PG8_WAIT_V(n) asm volatile("s_waitcnt vmcnt(" #n ")" ::: "memory")
#define PG8_WAIT_L(n) asm volatile("s_waitcnt lgkmcnt(" #n ")" ::: "memory")
#define PG8_BAR __builtin_amdgcn_s_barrier()
#define PG8_SCHED __builtin_amdgcn_sched_barrier(0)
    Unit cur, nxt; int ui = 0;
    if (!S.next(0, cur)) return;
    f32x4 acc[2][2][4][2];
#pragma unroll
    for (int a = 0; a < 2; ++a)
#pragma unroll
        for (int b = 0; b < 2; ++b)
#pragma unroll
            for (int m = 0; m < 4; ++m)
#pragma unroll
                for (int n = 0; n < 2; ++n) acc[a][b][m][n] = (f32x4){0.f, 0.f, 0.f, 0.f};
    bf16x8 At[4][2], B0[2][2], B1[2][2];
    const char* cA = (const char*)g.A; const char* cB = (const char*)g.Bt + (size_t)cur.pn * tstep;
    PG8_VOFF(cur, 0, va0, va1);
    S.a_ready(cur);
    if constexpr (SP2) {
        PG8_STAGE(PG8_SB(0, 0), cB, voffB); PG8_STAGE(PG8_SB(0, 1), cB + hstep, voffB); PG8_STAGE(PG8_SA(0, 0), cA, va0); PG8_STAGE(PG8_SA(0, 1), cA, va1);
        if (wr == 1) PG8_BAR;
        PG8_WAIT_V(2); PG8_BAR;
        PG8_STAGE(PG8_SB(1, 0), cB + kstep, voffB); PG8_STAGE(PG8_SA(1, 0), cA + kstep, va0); PG8_STAGE(PG8_SB(1, 1), cB + hstep + kstep, voffB);
        PG8_WAIT_V(6); PG8_BAR;
    } else {
        PG8_STAGE(PG8_SB(0, 0), cB, voffB); PG8_STAGE(PG8_SA(0, 0), cA, voffA); PG8_STAGE(PG8_SB(0, 1), cB + hstep, voffB); PG8_STAGE(PG8_SA(0, 1), cA + hstep, voffA);
        if (wr == 1) PG8_BAR;
        PG8_WAIT_V(4); PG8_BAR;
        PG8_STAGE(PG8_SB(1, 0), cB + kstep, voffB); PG8_STAGE(PG8_SA(1, 0), cA + kstep, voffA); PG8_STAGE(PG8_SB(1, 1), cB + hstep + kstep, voffB);
        PG8_WAIT_V(6); PG8_BAR;
    }
    for (;;) {
        const bool has_next = S.next(ui + 1, nxt);
        const char* nA = cA; const char* nB = has_next ? (const char*)g.Bt + (size_t)nxt.pn * tstep : cB;
#pragma unroll
        for (int seg = 0; seg < (MID ? 2 : 1); ++seg) {
        if constexpr (MID) { if (seg == 1) E.mid(acc, cur, wr, wc, fr, fq); }
#pragma unroll 1
        for (int t = (seg ? mid : 0); t < ((MID && seg == 0) ? mid : nt); t += 2) {
            const bool last = (t == nt - 2);
            if constexpr (MID) { if (t == mid - 2) E.pre_mid(); }
            const long sA1 = (MID && t >= mid) ? dA : 0, sA2 = (MID && t + 2 >= mid) ? dA : 0, sB2 = (MID && t + 2 >= mid) ? dB : 0;
            const char* a1 = cA + (size_t)(t + 1) * kstep + sA1;
            const char* a2 = last ? nA : cA + (size_t)(t + 2) * kstep + sA2; const char* b2 = last ? nB : cB + (size_t)(t + 2) * kstep + sB2;
            const char* a3 = a2 + kstep; const char* b3 = b2 + kstep;
            if (last && has_next) S.a_ready(nxt);
            if constexpr (SP2) {
            PG8_LDB(B0, 0, 0); PG8_LDB(B1, 0, 1); PG8_SCHED; PG8_LDA(At, 0, 0); PG8_STAGE(PG8_SA(1, 1), a1, va1);
            if (last && has_next) PG8_VOFF(nxt, ui + 1, va0, va1);
            PG8_WAIT_V(8); PG8_WAIT_L(0); PG8_BAR; PG8_MMA(0, 0, At, B0); PG8_MMA(0, 1, At, B1); PG8_BAR; PG8_SCHED;
            PG8_LDA(At, 0, 1); PG8_STAGE(PG8_SB(0, 0), b2, voffB); PG8_STAGE(PG8_SB(0, 1), b2 + hstep, voffB); PG8_STAGE(PG8_SA(0, 0), a2, va0);
            PG8_WAIT_V(8); PG8_WAIT_L(0); PG8_BAR; PG8_MMA(1, 0, At, B0); PG8_MMA(1, 1, At, B1); PG8_BAR; PG8_SCHED;
            PG8_LDB(B0, 1, 0); PG8_LDB(B1, 1, 1); PG8_SCHED; PG8_LDA(At, 1, 0); PG8_STAGE(PG8_SA(0, 1), a2, va1);
            PG8_WAIT_V(8); PG8_WAIT_L(0); PG8_BAR; PG8_MMA(0, 0, At, B0); PG8_MMA(0, 1, At, B1); PG8_BAR; PG8_SCHED;
            PG8_LDA(At, 1, 1); PG8_STAGE(PG8_SB(1, 0), b3, voffB); PG8_STAGE(PG8_SB(1, 1), b3 + hstep, voffB); PG8_STAGE(PG8_SA(1, 0), a3, va0);
            PG8_WAIT_V(8); PG8_WAIT_L(0); PG8_BAR; PG8_MMA(1, 0, At, B0); PG8_MMA(1, 1, At, B1); PG8_BAR; PG8_SCHED;
            } else {
            PG8_LDB(B0, 0, 0); PG8_SCHED; PG8_LDA(At, 0, 0); PG8_STAGE(PG8_SA(1, 1), a1 + hstep, voffA);
            PG8_WAIT_L(8); PG8_BAR; PG8_WAIT_L(0); PG8_MMA(0, 0, At, B0); PG8_BAR; PG8_SCHED;
            PG8_LDB(B1, 0, 1); PG8_STAGE(PG8_SB(0, 0), b2, voffB);
            PG8_BAR; PG8_WAIT_L(0); PG8_MMA(0, 1, At, B1); PG8_BAR;
            PG8_LDA(At, 0, 1); PG8_STAGE(PG8_SA(0, 0), a2, voffA);
            PG8_BAR; PG8_WAIT_L(0); PG8_MMA(1, 0, At, B0); PG8_BAR; PG8_SCHED;
            PG8_STAGE(PG8_SB(0, 1), b2 + hstep, voffB);
            PG8_WAIT_V(6); PG8_BAR; PG8_MMA(1, 1, At, B1); PG8_BAR;
            PG8_LDB(B0, 1, 0); PG8_SCHED; PG8_LDA(At, 1, 0); PG8_STAGE(PG8_SA(0, 1), a2 + hstep, voffA);
            PG8_WAIT_L(8); PG8_BAR; PG8_WAIT_L(0); PG8_MMA(0, 0, At, B0); PG8_BAR; PG8_SCHED;
            PG8_LDB(B1, 1, 1); PG8_STAGE(PG8_SB(1, 0), b3, voffB);
            PG8_BAR; PG8_WAIT_L(0); PG8_MMA(0, 1, At, B1); PG8_BAR;
            PG8_LDA(At, 1, 1); PG8_STAGE(PG8_SA(1, 0), a3, voffA);
            PG8_BAR; PG8_WAIT_L(0); PG8_MMA(1, 0, At, B0); PG8_BAR; PG8_SCHED;
            PG8_STAGE(PG8_SB(1, 1), b3 + hstep, voffB);
            PG8_WAIT_V(6); PG8_BAR; PG8_MMA(1, 1, At, B1); PG8_BAR;
            }
        }
        }
        if constexpr (ALIGN_EPI) { if (wr == 0) PG8_BAR; }
        if constexpr (!Epi::AFTER_DRAIN) { E(acc, cur, wr, wc, fr, fq); S.done(cur); }
        if (!has_next) break;
#pragma unroll
        for (int a = 0; a < 2; ++a)
#pragma unroll
            for (int b = 0; b < 2; ++b)
#pragma unroll
                for (int m = 0; m < 4; ++m)
#pragma unroll
                    for (int n = 0; n < 2; ++n) acc[a][b][m][n] = (f32x4){0.f, 0.f, 0.f, 0.f};
        cur = nxt; cA = nA; cB = nB; ++ui;
        if constexpr (ALIGN_EPI) { if (wr == 1) PG8_BAR; }
    }
    PG8_WAIT_V(0);
    if constexpr (!ALIGN_EPI) { if (wr == 0) PG8_BAR; }
    PG8_BAR;
    if constexpr (Epi::AFTER_DRAIN) { E.fused(acc, cur, wr, wc, fr, fq, lds, wid, lane); S.done(cur); }
#undef PG8_VOFF
#undef PG8_SA
#undef PG8_SB
#undef PG8_STAGE
#undef PG8_LDA
#undef PG8_LDB
#undef PG8_MMA
#undef PG8_CAT
#undef PG8_WAIT_V
#undef PG8_WAIT_L
#undef PG8_BAR
#undef PG8_SCHED
}
}
namespace attn_body {
using bf16=unsigned short;
using bf16x8=__attribute__((ext_vector_type(8)))short;
using s16x4=__attribute__((ext_vector_type(4)))short;
using f32x16=__attribute__((ext_vector_type(16)))float;
using u32x4=__attribute__((ext_vector_type(4)))unsigned;
constexpr int BATCH=2,NHEAD=16,SEQ=8192,D=64,DM=NHEAD*D;
constexpr int NW=8,QBLK=32,QB=QBLK*NW,KVBLK=64,NQB=SEQ/QB;
constexpr int ATTN_PITCH=DM, ATTN_UNIT_ROWS=QB;
__device__ __forceinline__ int crow(int r,int hi){return (r&3)+8*(r>>2)+4*hi;}
#define SBAR() __builtin_amdgcn_sched_barrier(0)
__device__ __forceinline__ void cmask(f32x16&p0,f32x16&p1,int jb,int qrel,int hi){
  const float NEG=-INFINITY; int kb=64*jb+4*hi;
  #pragma unroll
  for(int r=0;r<16;++r){int kv=kb+(r&3)+8*(r>>2); if(kv>qrel)p0[r]=NEG; if(kv+32>qrel)p1[r]=NEG;}
}

constexpr int NSLOT=3, SLOTB=8192;
constexpr int VSLOTB=16384;
constexpr int LDS_K=0, LDS_V=NSLOT*SLOTB, LDS_WS=LDS_V+NSLOT*VSLOTB, LDS_OST=LDS_WS+NW*64*4, LDS_BYTES=LDS_OST+NW*8192;
constexpr float C2=0.125f*1.4426950408889634f;
__device__ __forceinline__ void glds16(const void*gsrc,unsigned lds_dst){unsigned keep;
  asm volatile("s_mov_b32 %0, m0\n\ts_mov_b32 m0, %2\n\ts_nop 0\n\tglobal_load_lds_dwordx4 %1, off\n\ts_mov_b32 m0, %0":"=&s"(keep):"v"(gsrc),"s"(lds_dst):"memory");}
__device__ __forceinline__ float max3f(float a,float b,float c){float r;asm("v_max3_f32 %0, %1, %2, %3":"=v"(r):"v"(a),"v"(b),"v"(c));return r;}
__device__ __forceinline__ float max2f(float a,float b){float r;asm("v_max_f32_e32 %0, %1, %2":"=v"(r):"v"(a),"v"(b));return r;}
__device__ __forceinline__ float fadd_s(float a,float b){float r;asm("v_add_f32_e32 %0, %1, %2":"=v"(r):"v"(a),"v"(b));return r;}
__device__ __forceinline__ float fsub_s(float a,float b){float r;asm("v_sub_f32_e32 %0, %1, %2":"=v"(r):"v"(a),"v"(b));return r;}
typedef float f32x2_t __attribute__((ext_vector_type(2))); typedef __bf16 bf16x2_t __attribute__((ext_vector_type(2)));
__device__ __forceinline__ unsigned cvtpk_s(float lo,float hi){f32x2_t v={lo,hi};bf16x2_t b=__builtin_convertvector(v,bf16x2_t);return __builtin_bit_cast(unsigned,b);}
#define WAIT_BAR(N) asm volatile("s_waitcnt vmcnt(" #N ") lgkmcnt(0)\n\ts_barrier":::"memory")

__device__ __forceinline__ void qkt(f32x16&p0,f32x16&p1,const char*Kslot,const bf16x8*qr,const f32x16&negm,int r32,int hi){
  const char*kb=Kslot+hi*1024+r32*16;
  #pragma unroll
  for(int d0=0;d0<4;++d0){
    const bf16x8 b0=*reinterpret_cast<const bf16x8*>(kb+d0*2048);
    const bf16x8 b1=*reinterpret_cast<const bf16x8*>(kb+d0*2048+512);
    if(d0==0){p0=__builtin_amdgcn_mfma_f32_32x32x16_bf16(b0,qr[0],negm,0,0,0);p1=__builtin_amdgcn_mfma_f32_32x32x16_bf16(b1,qr[0],negm,0,0,0);}
    else{p0=__builtin_amdgcn_mfma_f32_32x32x16_bf16(b0,qr[d0],p0,0,0,0);p1=__builtin_amdgcn_mfma_f32_32x32x16_bf16(b1,qr[d0],p1,0,0,0);}}
}
typedef __attribute__((address_space(3))) const char* lds_cptr;
typedef short v4i16_t __attribute__((ext_vector_type(4)));
__device__ __forceinline__ void kload8(bf16x8*kf,lds_cptr kp){
  kf[0]=*(const __attribute__((address_space(3))) bf16x8*)(kp);      kf[1]=*(const __attribute__((address_space(3))) bf16x8*)(kp+512);
  kf[2]=*(const __attribute__((address_space(3))) bf16x8*)(kp+2048); kf[3]=*(const __attribute__((address_space(3))) bf16x8*)(kp+2560);
  kf[4]=*(const __attribute__((address_space(3))) bf16x8*)(kp+4096); kf[5]=*(const __attribute__((address_space(3))) bf16x8*)(kp+4608);
  kf[6]=*(const __attribute__((address_space(3))) bf16x8*)(kp+6144); kf[7]=*(const __attribute__((address_space(3))) bf16x8*)(kp+6656);
}
__device__ __forceinline__ void kload2(bf16x8*kf,lds_cptr kp,int j){ kf[2*j]=*(const __attribute__((address_space(3))) bf16x8*)(kp+j*2048); kf[2*j+1]=*(const __attribute__((address_space(3))) bf16x8*)(kp+j*2048+512); }
__device__ __forceinline__ s16x4 vtr(lds_cptr p){ return __builtin_bit_cast(s16x4,__builtin_amdgcn_ds_read_tr16_b64_v4i16((__attribute__((address_space(3))) v4i16_t*)p)); }
__device__ __forceinline__ float rowmax(const f32x16&p0,const f32x16&p1){
  float a=max3f(p0[0],p0[1],p1[0]),b=max3f(p0[2],p0[3],p1[1]);a=max3f(a,p1[2],p1[3]);
  #pragma unroll
  for(int r=4;r<16;r+=4){a=max3f(a,p0[r],p0[r+1]);b=max3f(b,p0[r+2],p0[r+3]);a=max3f(a,p1[r],p1[r+1]);b=max3f(b,p1[r+2],p1[r+3]);}
  const float m=max2f(a,b);
  auto rr=__builtin_amdgcn_permlane32_swap(__float_as_uint(m),__float_as_uint(m),false,false);
  return max2f(__uint_as_float(rr[0]),__uint_as_float(rr[1]));
}
__device__ __forceinline__ void pv(f32x16*o,int vb,bf16x8 pa0,bf16x8 pa1,bf16x8 pa2,bf16x8 pa3){
  #pragma unroll
  for(int d0=0;d0<4;++d0){s16x4 lo[4],hi[4];
    #pragma unroll
    for(int ks=0;ks<4;++ks){
      asm volatile("ds_read_b64_tr_b16 %0,%1 offset:%c2":"=&v"(lo[ks]):"v"(vb),"i"(d0*4096+ks*1024):"memory");
      asm volatile("ds_read_b64_tr_b16 %0,%1 offset:%c2":"=&v"(hi[ks]):"v"(vb),"i"(d0*4096+ks*1024+512):"memory");}
    asm volatile("s_waitcnt lgkmcnt(0)":::"memory");SBAR();
    #define PK(k) (bf16x8){lo[k][0],lo[k][1],lo[k][2],lo[k][3],hi[k][0],hi[k][1],hi[k][2],hi[k][3]}
    o[d0]=__builtin_amdgcn_mfma_f32_32x32x16_bf16(pa0,PK(0),o[d0],0,0,0);
    o[d0]=__builtin_amdgcn_mfma_f32_32x32x16_bf16(pa1,PK(1),o[d0],0,0,0);
    o[d0]=__builtin_amdgcn_mfma_f32_32x32x16_bf16(pa2,PK(2),o[d0],0,0,0);
    o[d0]=__builtin_amdgcn_mfma_f32_32x32x16_bf16(pa3,PK(3),o[d0],0,0,0);
    #undef PK
  }
}

#ifndef ATTN_STORE16
#define ATTN_STORE16(p,v) (*(u32x4*)(p)=(v))
#endif
template<int THRL> __device__ __forceinline__ void attn_unit(int b,int h,int qb,int vcol,const bf16*Q,const bf16*__restrict__ K,const bf16*__restrict__ V,bf16*Ob,int opitch,char*shm){
  int tid_=threadIdx.x; asm volatile("":"+v"(tid_)); const int tid=tid_,lane=tid&63,r32=lane&31,hi=lane>>5; const int wid=__builtin_amdgcn_readfirstlane(tid>>6);
  const long rowbase=(long)b*SEQ; const int q0=qb*QB;
  const bf16*Qw=Q+(rowbase+q0+wid*QBLK)*DM+h*D;
  const bf16*Kh=K+rowbase*DM+h*D,*Vh=V+rowbase*DM+vcol;
  const unsigned lds0=(unsigned)(uintptr_t)shm;
  float*wsf=(float*)(shm+LDS_WS)+wid*64;
  const bf16*ksrc=Kh+(long)lane*DM+wid*8;
  const bf16*vsrc=Vh+(long)(16*(wid&3)+(lane>>2))*DM+(wid>>2)*32+(lane&3)*8;
  const unsigned kdst=lds0+LDS_K+wid*1024, vdst=lds0+LDS_V+wid*1024;
  #define DMA_K(t,slot) glds16(ksrc+(long)(t)*KVBLK*DM,(unsigned)__builtin_amdgcn_readfirstlane(kdst+(slot)))
  #define DMA_V(t,slot) do{ glds16(vsrc+(long)(t)*KVBLK*DM,(unsigned)__builtin_amdgcn_readfirstlane(vdst+2*(slot))); glds16(vsrc+(long)(t)*KVBLK*DM+64,(unsigned)__builtin_amdgcn_readfirstlane(vdst+2*(slot)+8192)); }while(0)
  const int vb0=(int)(lds0+LDS_V)+((lane>>4)&1)*32+(lane&3)*8+(4*hi+((lane&15)>>2))*64;
  const char*Kbase=shm+LDS_K; bf16x8 kf[8];
  const lds_cptr shm3=(lds_cptr)shm; const lds_cptr kp0=shm3+LDS_K+hi*1024+r32*16; const lds_cptr vp0=shm3+LDS_V+((lane>>4)&1)*32+(lane&3)*8+(4*hi+((lane&15)>>2))*64;
  const int NT=(q0+QB)/KVBLK;
  DMA_K(0,0);DMA_V(0,0);DMA_K(1,SLOTB);
  bf16x8 qr[4];
  #pragma unroll
  for(int d0=0;d0<4;++d0)qr[d0]=*reinterpret_cast<const bf16x8*>(&Qw[(long)r32*DM+d0*16+hi*8]);
  const lds_cptr qp0=shm3+LDS_OST+wid*8192+lane*16;
  #pragma unroll
  for(int d0=0;d0<4;++d0)*(__attribute__((address_space(3))) bf16x8*)(qp0+d0*1024)=qr[d0];
  #define QF(i) (*(const __attribute__((address_space(3))) bf16x8*)(qp0+(i)*1024))
  float mhat=0.f,l_reg=0.f;f32x16 o[4];o[0]=f32x16{};o[1]=f32x16{};o[2]=f32x16{};o[3]=f32x16{};const f32x16 zc=f32x16{};
  const int qrel=wid*QBLK+r32;
  #define CMASK(P0,P1,t) do{int jb_=(t)-(NT-4); if(jb_>=0)cmask(P0,P1,jb_,qrel,hi);}while(0)
  bool resc=false;
  #define START(P0,P1) do{ const float rm=rowmax(P0,P1); resc=false; \
    { const float dl=(rm>(float)THRL)?rm:0.f; mhat=fadd_s(mhat,dl); \
      _Pragma("unroll") for(int r=0;r<16;++r){P0[r]=fsub_s(P0[r],dl);P1[r]=fsub_s(P1[r],dl);} \
      } \
    _Pragma("unroll") for(int r=0;r<16;++r)P0[r]=__builtin_amdgcn_exp2f(P0[r]); }while(0)
  #define RESC() do{ if(resc){ asm volatile("s_waitcnt lgkmcnt(0)":::"memory"); \
      _Pragma("unroll") for(int d_=0;d_<4;++d_) _Pragma("unroll") for(int r=0;r<16;++r)o[d_][r]*=wsf[crow(r,hi)]; } }while(0)
  f32x16 pA0,pA1,pB0,pB1;
  int sl_prev=0,sl_cur=0,sl_next=SLOTB;
  #define ROT() do{sl_prev=sl_cur;sl_cur=sl_next;sl_next=(sl_next==(NSLOT-1)*SLOTB)?0:sl_next+SLOTB;}while(0)
  DMA_K(2,2*SLOTB);
  WAIT_BAR(4);
  qkt(pA0,pA1,Kbase,qr,zc,r32,hi);asm volatile("s_nop 15\n\ts_nop 7":"+v"(pA0),"+v"(pA1));CMASK(pA0,pA1,0);
  START(pA0,pA1);
  _Pragma("unroll") for(int r=0;r<16;++r)pA1[r]=__builtin_amdgcn_exp2f(pA1[r]);
  WAIT_BAR(0);
  DMA_K(3,0);DMA_V(1,SLOTB);
  ROT();
  kload8(kf,kp0+sl_cur);
  WAIT_BAR(3);
  s16x4 vlo[8],vhi[8]; u32x4 pw0,pw1,pw2,pw3;
  #define PKW(P,B) cvtpk_s(P[B],P[B+1])
  #define PAF(k) __builtin_bit_cast(bf16x8,pw##k)
  #define VFR(i) (bf16x8){vlo[i][0],vlo[i][1],vlo[i][2],vlo[i][3],vhi[i][0],vhi[i][1],vhi[i][2],vhi[i][3]}
  #define PIN(x) asm volatile("":"+v"(x))
  #define MX3(a,b,c) __builtin_fmaxf(__builtin_fmaxf((a),(b)),(c))
  #define GAPA(MF,A0,A1,A2,A3,W0,W1,PW) do{ MF; sacc+=A0; sacc+=A1; sacc+=A2; sacc+=A3; PIN(sacc); W0; W1; PIN(PW); SBAR(); }while(0)
  #define EX(v) __builtin_amdgcn_exp2f(v)
  #define GAPB(MF,X,B) do{ MF; X[B]=EX(X[B]); X[B+1]=EX(X[B+1]); X[B+2]=EX(X[B+2]); X[B+3]=EX(X[B+3]); PIN(X); SBAR(); }while(0)
  #define VRD(i) do{ vlo[i]=vtr(vp_+(((i)>>2)*4096+((i)&3)*1024)); vhi[i]=vtr(vp_+(((i)>>2)*4096+((i)&3)*1024+512)); }while(0)
  #define VRD2(i) do{ vlo[i]=vtr(vp_+(8192+((i)>>2)*4096+((i)&3)*1024)); vhi[i]=vtr(vp_+(8192+((i)>>2)*4096+((i)&3)*1024+512)); SBAR(); }while(0)
  #define GAPB2(MF,X,B) do{ MF; X[B]=EX(X[B]); X[B+1]=EX(X[B+1]); PIN(X); SBAR(); }while(0)
  #define KRD(G,j) do{ if(G){ kload2(kf,kp0+sl_next,j); SBAR(); } }while(0)
  #define STEP(C0,C1,P0,P1,t,GK,GV,GL) do{ SBAR(); \
    const lds_cptr vp_=vp0+2*sl_prev; \
    VRD(0); bf16x8 qe_=QF(0); SBAR(); float sacc=(P0[0]+P0[1]); \
    GAPA(C0=__builtin_amdgcn_mfma_f32_32x32x16_bf16(kf[0],qe_,zc,0,0,0), P0[2],P0[3],P0[4],P0[5],     pw0[0]=PKW(P0,0), pw0[1]=PKW(P0,2), pw0); \
    bf16x8 qo_=QF(1); SBAR(); GAPA(C1=__builtin_amdgcn_mfma_f32_32x32x16_bf16(kf[1],qe_,zc,0,0,0), P0[6],P0[7],P0[8],P0[9],     pw0[2]=PKW(P0,4), pw0[3]=PKW(P0,6), pw0); \
    VRD(1); SBAR(); GAPA(C0=__builtin_amdgcn_mfma_f32_32x32x16_bf16(kf[2],qo_,C0,0,0,0),   P0[10],P0[11],P0[12],P0[13], pw1[0]=PKW(P0,8), pw1[1]=PKW(P0,10), pw1); \
    qe_=QF(2); SBAR(); GAPA(C1=__builtin_amdgcn_mfma_f32_32x32x16_bf16(kf[3],qo_,C1,0,0,0),   P0[14],P0[15],P1[0],P1[1],   pw1[2]=PKW(P0,12),pw1[3]=PKW(P0,14), pw1); \
    VRD(2); SBAR(); GAPA(C0=__builtin_amdgcn_mfma_f32_32x32x16_bf16(kf[4],qe_,C0,0,0,0),   P1[2],P1[3],P1[4],P1[5],     pw2[0]=PKW(P1,0), pw2[1]=PKW(P1,2), pw2); \
    qo_=QF(3); SBAR(); GAPA(C1=__builtin_amdgcn_mfma_f32_32x32x16_bf16(kf[5],qe_,C1,0,0,0),   P1[6],P1[7],P1[8],P1[9],     pw2[2]=PKW(P1,4), pw2[3]=PKW(P1,6), pw2); \
    VRD(3); SBAR(); GAPA(C0=__builtin_amdgcn_mfma_f32_32x32x16_bf16(kf[6],qo_,C0,0,0,0),   P1[10],P1[11],P1[12],P1[13], pw3[0]=PKW(P1,8), pw3[1]=PKW(P1,10), pw3); \
    VRD(4); SBAR(); GAPA(C1=__builtin_amdgcn_mfma_f32_32x32x16_bf16(kf[7],qo_,C1,0,0,0),   P1[14],P1[15],0.f,0.f,       pw3[2]=PKW(P1,12),pw3[3]=PKW(P1,14), pw3); \
    l_reg+=sacc; \
    if(__any(mhat!=0.f)){ _Pragma("unroll") for(int r=0;r<16;++r){C0[r]-=mhat;C1[r]-=mhat;} } \
    if(GK){DMA_K((t)+3,sl_cur);} if(GV){DMA_V((t)+1,sl_next);} \
    CMASK(C0,C1,t); \
    { float a=MX3(C0[0],C0[1],C1[0]),b=MX3(C0[2],C0[3],C1[1]); a=MX3(a,C1[2],C1[3]); \
      _Pragma("unroll") for(int r=4;r<16;r+=4){a=MX3(a,C0[r],C0[r+1]);b=MX3(b,C0[r+2],C0[r+3]);a=MX3(a,C1[r],C1[r+1]);b=MX3(b,C1[r+2],C1[r+3]);} \
      float rm=__builtin_fmaxf(a,b); { auto rr=__builtin_amdgcn_permlane32_swap(__float_as_uint(rm),__float_as_uint(rm),false,false); rm=__builtin_fmaxf(__uint_as_float(rr[0]),__uint_as_float(rr[1])); } \
      resc=false; \
      if(__builtin_expect(__any(rm>(float)THRL),0)){ const float dl=__builtin_fmaxf(rm,0.f); mhat+=dl; \
        _Pragma("unroll") for(int r=0;r<16;++r){C0[r]-=dl;C1[r]-=dl;} \
        const float f=__builtin_amdgcn_exp2f(-dl); l_reg*=f; if(hi==0)wsf[r32]=f; resc=true; } } \
    SBAR(); \
    GAPB2(o[0]=__builtin_amdgcn_mfma_f32_32x32x16_bf16(PAF(0),VFR(0),o[0],0,0,0), C0,0); VRD(5); SBAR(); VRD2(0); \
    GAPB2(o[1]=__builtin_amdgcn_mfma_f32_32x32x16_bf16(PAF(0),VFR(4),o[1],0,0,0), C0,2); VRD2(4); \
    KRD(GL,0); GAPB2(o[0]=__builtin_amdgcn_mfma_f32_32x32x16_bf16(PAF(1),VFR(1),o[0],0,0,0), C0,4); VRD(6); SBAR(); VRD2(1); \
    KRD(GL,1); GAPB2(o[1]=__builtin_amdgcn_mfma_f32_32x32x16_bf16(PAF(1),VFR(5),o[1],0,0,0), C0,6); VRD2(5); \
    KRD(GL,2); GAPB2(o[0]=__builtin_amdgcn_mfma_f32_32x32x16_bf16(PAF(2),VFR(2),o[0],0,0,0), C0,8); VRD(7); SBAR(); VRD2(2); \
    KRD(GL,3); GAPB2(o[1]=__builtin_amdgcn_mfma_f32_32x32x16_bf16(PAF(2),VFR(6),o[1],0,0,0), C0,10); VRD2(6); \
    GAPB2(o[0]=__builtin_amdgcn_mfma_f32_32x32x16_bf16(PAF(3),VFR(3),o[0],0,0,0), C0,12); VRD2(3); \
    GAPB2(o[1]=__builtin_amdgcn_mfma_f32_32x32x16_bf16(PAF(3),VFR(7),o[1],0,0,0), C0,14); VRD2(7); \
    GAPB2(o[2]=__builtin_amdgcn_mfma_f32_32x32x16_bf16(PAF(0),VFR(0),o[2],0,0,0), C1,0); \
    GAPB2(o[3]=__builtin_amdgcn_mfma_f32_32x32x16_bf16(PAF(0),VFR(4),o[3],0,0,0), C1,2); \
    GAPB2(o[2]=__builtin_amdgcn_mfma_f32_32x32x16_bf16(PAF(1),VFR(1),o[2],0,0,0), C1,4); \
    GAPB2(o[3]=__builtin_amdgcn_mfma_f32_32x32x16_bf16(PAF(1),VFR(5),o[3],0,0,0), C1,6); \
    GAPB2(o[2]=__builtin_amdgcn_mfma_f32_32x32x16_bf16(PAF(2),VFR(2),o[2],0,0,0), C1,8); \
    GAPB2(o[3]=__builtin_amdgcn_mfma_f32_32x32x16_bf16(PAF(2),VFR(6),o[3],0,0,0), C1,10); \
    GAPB2(o[2]=__builtin_amdgcn_mfma_f32_32x32x16_bf16(PAF(3),VFR(3),o[2],0,0,0), C1,12); \
    GAPB2(o[3]=__builtin_amdgcn_mfma_f32_32x32x16_bf16(PAF(3),VFR(7),o[3],0,0,0), C1,14); \
    }while(0)
  int t=1;
  #undef CMASK
  #define CMASK(P0,P1,t) do{}while(0)
  for(;t+5<NT;t+=2){
    STEP(pB0,pB1,pA0,pA1,t,true,true,true);     WAIT_BAR(3); RESC(); ROT();
    STEP(pA0,pA1,pB0,pB1,t+1,true,true,true);   WAIT_BAR(3); RESC(); ROT();
  }
  #undef CMASK
  #define CMASK(P0,P1,t) do{int jb_=(t)-(NT-4); if(jb_>=0)cmask(P0,P1,jb_,qrel,hi);}while(0)
  #define ENDW(tt) do{ if((tt)+3<NT){WAIT_BAR(3);} else if((tt)+2<NT){WAIT_BAR(2);} else {WAIT_BAR(0);} }while(0)
  for(;t+1<NT;t+=2){
    STEP(pB0,pB1,pA0,pA1,t,(t+3<NT),(t+1<NT),(t+1<NT));       ENDW(t);   RESC(); ROT();
    STEP(pA0,pA1,pB0,pB1,t+1,(t+4<NT),(t+2<NT),(t+2<NT));     ENDW(t+1); RESC(); ROT();
  }
  STEP(pB0,pB1,pA0,pA1,NT-1,false,false,false); RESC();
  { float sacc=pB0[0]+pB0[1]; _Pragma("unroll") for(int r=2;r<16;++r)sacc+=pB0[r]; _Pragma("unroll") for(int r=0;r<16;++r)sacc+=pB1[r]; l_reg+=sacc;
    pw0=(u32x4){PKW(pB0,0),PKW(pB0,2),PKW(pB0,4),PKW(pB0,6)};pw1=(u32x4){PKW(pB0,8),PKW(pB0,10),PKW(pB0,12),PKW(pB0,14)};pw2=(u32x4){PKW(pB1,0),PKW(pB1,2),PKW(pB1,4),PKW(pB1,6)};pw3=(u32x4){PKW(pB1,8),PKW(pB1,10),PKW(pB1,12),PKW(pB1,14)};
    SBAR(); pv(o,vb0+2*sl_cur,PAF(0),PAF(1),PAF(2),PAF(3)); }
  #undef PKW
  #undef PAF
  #undef VFR
  #undef PIN
  #undef MX3
  #undef GAPA
  #undef GAPB
  #undef EX
  #undef VRD
  #undef VRD2
  #undef QF
  #undef GAPB2
  #undef KRD
  #undef STEP
  #undef ENDW
  {auto rr=__builtin_amdgcn_permlane32_swap(__float_as_uint(l_reg),__float_as_uint(l_reg),false,false);l_reg=__uint_as_float(rr[0])+__uint_as_float(rr[1]);}
  if(hi==0)wsf[32+r32]=l_reg;asm volatile("s_waitcnt lgkmcnt(0)":::"memory");
  float rli[16];
  #pragma unroll
  for(int r=0;r<16;++r)rli[r]=__builtin_amdgcn_rcpf(wsf[32+crow(r,hi)]);
  bf16*Ow=Ob+(long)(wid*QBLK)*opitch;
  { bf16*stg=(bf16*)(shm+LDS_OST)+wid*4096;
    #pragma unroll
    for(int r=0;r<16;++r){const int orow=crow(r,hi);
      #pragma unroll
      for(int d0=0;d0<4;++d0)stg[orow*128+d0*32+r32]=(bf16)f2bf(o[d0][r]*rli[r]);}
    asm volatile("s_waitcnt lgkmcnt(0)":::"memory");
    #pragma unroll
    for(int i=0;i<8;++i){const int row=i*4+(lane>>4),ch=lane&15; const u32x4 v=*(const u32x4*)(stg+row*128+ch*8); ATTN_STORE16(Ow+(long)row*opitch+ch*8,v);} }
  asm volatile("s_waitcnt lgkmcnt(0)\n\ts_barrier":::"memory");
  #undef DMA_K
  #undef DMA_V
  #undef CMASK
  #undef START
  #undef RESC
  #undef ROT
}
constexpr int ATTN_LDS_BYTES=LDS_BYTES;
#undef SBAR
#undef WAIT_BAR
}
namespace mk {
using pg8::Unit; using pg8::BM; using pg8::HALF;
typedef __bf16 bf16x2_t __attribute__((ext_vector_type(2)));
__device__ __forceinline__ unsigned cvtpk(float lo, float hi) { const f32x2 v = {lo, hi}; const bf16x2_t b = __builtin_convertvector(v, bf16x2_t); return __builtin_bit_cast(unsigned, b); }
__device__ __forceinline__ v4u pack8(f32x4 a, f32x4 b) { v4u w; w.x = cvtpk(a[0], a[1]); w.y = cvtpk(a[2], a[3]); w.z = cvtpk(b[0], b[1]); w.w = cvtpk(b[2], b[3]); return w; }
__device__ __forceinline__ f32x4 up_lo(v4u w) { return (f32x4){__builtin_bit_cast(float, w.x << 16), __builtin_bit_cast(float, w.x & 0xffff0000u), __builtin_bit_cast(float, w.y << 16), __builtin_bit_cast(float, w.y & 0xffff0000u)}; }
__device__ __forceinline__ f32x4 up_hi(v4u w) { return (f32x4){__builtin_bit_cast(float, w.z << 16), __builtin_bit_cast(float, w.z & 0xffff0000u), __builtin_bit_cast(float, w.w << 16), __builtin_bit_cast(float, w.w & 0xffff0000u)}; }
__device__ __forceinline__ float fsig(float x) { return __builtin_amdgcn_rcpf(1.f + __builtin_amdgcn_exp2f(-1.4426950408889634f * x)); }
__device__ __forceinline__ f32x4 sig4(f32x4 v) { return (f32x4){fsig(v[0]), fsig(v[1]), fsig(v[2]), fsig(v[3])}; }
__device__ __forceinline__ f32x4 silu4(f32x4 v) { return v * sig4(v); }
__device__ __forceinline__ float fden(float x) { return fminf(1.f + __builtin_amdgcn_exp2f(-1.4426950408889634f * x), 1e30f); }
__device__ __forceinline__ f32x4 den4(f32x4 v) { return (f32x4){fden(v[0]), fden(v[1]), fden(v[2]), fden(v[3])}; }

struct TrItem { const float* W; size_t ldw; int k0, c0; bf16* WT; size_t ldt; int drow0; };
__device__ __forceinline__ void transpose_load(const TrItem& t, f32x4 (&v)[8], int lane) {
#pragma unroll
    for (int i = 0; i < 8; ++i) v[i] = __builtin_nontemporal_load((const f32x4*)(t.W + (size_t)(t.k0 + (lane >> 3) + 8 * i) * t.ldw + t.c0 + 4 * (lane & 7)));
}
__device__ __forceinline__ void transpose_finish(const TrItem& t, const f32x4 (&v)[8], LAS float* scr, int lane) {
#pragma unroll
    for (int i = 0; i < 8; ++i) { LAS float* d = scr + ((lane >> 3) + 8 * i) * 33 + 4 * (lane & 7); d[0] = v[i][0]; d[1] = v[i][1]; d[2] = v[i][2]; d[3] = v[i][3]; }
    asm volatile("s_waitcnt lgkmcnt(0)" ::: "memory");
    const int c = lane & 7;
#pragma unroll
    for (int j = 0; j < 4; ++j) { const int n = (lane >> 3) + 8 * j; const LAS float* s = scr + (8 * c) * 33 + n;
        v4u o; o.x = pk2(s[0 * 33], s[1 * 33]); o.y = pk2(s[2 * 33], s[3 * 33]); o.z = pk2(s[4 * 33], s[5 * 33]); o.w = pk2(s[6 * 33], s[7 * 33]);
        *(GAS v4u*)(t.WT + (size_t)(t.drow0 + n) * t.ldt + t.k0 + 8 * c) = o; }
    asm volatile("s_waitcnt lgkmcnt(0)" ::: "memory");
}
__device__ __forceinline__ unsigned pk4_fp8(float a, float b, float c, float d) { int w = __builtin_amdgcn_cvt_pk_fp8_f32(a, b, 0, false); w = __builtin_amdgcn_cvt_pk_fp8_f32(c, d, w, true); return (unsigned)w; }
__device__ __forceinline__ float clamp8(float x) { return __builtin_amdgcn_fmed3f(x, -448.f, 448.f); }
__device__ __forceinline__ int dmap_row(int L) { return (L & ~255) + ((L >> 3) & 1) * 128 + ((L >> 6) & 3) * 32 + ((L >> 4) & 3) * 8 + (L & 7); }
__device__ __forceinline__ void transpose_finish8(const TrItem& t, const f32x4 (&v)[8], LAS float* scr, int lane, float scale, bool dm = false) {
#pragma unroll
    for (int i = 0; i < 8; ++i) { LAS float* d = scr + ((lane >> 3) + 8 * i) * 33 + 4 * (lane & 7); d[0] = v[i][0]; d[1] = v[i][1]; d[2] = v[i][2]; d[3] = v[i][3]; }
    asm volatile("s_waitcnt lgkmcnt(0)" ::: "memory");
    const int n = lane & 31, kh = lane >> 5; const LAS float* s = scr + (32 * kh) * 33 + n;
    unsigned w[8];
#pragma unroll
    for (int j = 0; j < 8; ++j) w[j] = pk4_fp8(s[(4 * j) * 33] * scale, s[(4 * j + 1) * 33] * scale, s[(4 * j + 2) * 33] * scale, s[(4 * j + 3) * 33] * scale);
    unsigned char* o = (unsigned char*)t.WT + (size_t)(dm ? dmap_row(t.drow0 + n) : t.drow0 + n) * t.ldt + t.k0 + 32 * kh;
    *(GAS v4u*)o = (v4u){w[0], w[1], w[2], w[3]}; *(GAS v4u*)(o + 16) = (v4u){w[4], w[5], w[6], w[7]};
    asm volatile("s_waitcnt lgkmcnt(0)" ::: "memory");
}
template <bool PERMK = false>
__device__ __forceinline__ void transpose_finish8g(const TrItem& t, const f32x4 (&v)[8], LAS float* scr, int lane, float scale, const float* gain) {
#pragma unroll
    for (int i = 0; i < 8; ++i) { LAS float* d = scr + ((lane >> 3) + 8 * i) * 33 + 4 * (lane & 7); d[0] = v[i][0]; d[1] = v[i][1]; d[2] = v[i][2]; d[3] = v[i][3]; }
    asm volatile("s_waitcnt lgkmcnt(0)" ::: "memory");
    const int n = lane & 31, kh = lane >> 5; const LAS float* s = scr + (32 * kh) * 33 + n;
    f32x4 gk[8];
#pragma unroll
    for (int j = 0; j < 8; ++j) gk[j] = *(const f32x4*)(gain + 32 * kh + 4 * j) * scale;
    unsigned w[8];
#pragma unroll
    for (int j = 0; j < 8; ++j) w[j] = pk4_fp8(s[(4 * j) * 33] * gk[j][0], s[(4 * j + 1) * 33] * gk[j][1], s[(4 * j + 2) * 33] * gk[j][2], s[(4 * j + 3) * 33] * gk[j][3]);
    if constexpr (PERMK) { unsigned char* o = (unsigned char*)t.WT + (size_t)(t.drow0 + n) * t.ldt + t.k0 + 8 * kh;
#pragma unroll
        for (int j = 0; j < 4; ++j) *(GAS v2u*)(o + 16 * j) = (v2u){w[j], w[j + 4]}; }
    else { unsigned char* o = (unsigned char*)t.WT + (size_t)(t.drow0 + n) * t.ldt + t.k0 + 32 * kh;
        *(GAS v4u*)o = (v4u){w[0], w[1], w[2], w[3]}; *(GAS v4u*)(o + 16) = (v4u){w[4], w[5], w[6], w[7]}; }
    asm volatile("s_waitcnt lgkmcnt(0)" ::: "memory");
}
__device__ __forceinline__ void transpose_item(const float* W, size_t ldw, int k0, int c0, bf16* WT, size_t ldt, int drow0, LAS float* scr, int lane) {
    const TrItem t{W, ldw, k0, c0, WT, ldt, drow0}; f32x4 v[8]; transpose_load(t, v, lane); transpose_finish(t, v, scr, lane);
}
__device__ __forceinline__ int win_drow(int c0) {
    if (c0 >= C_V) return c0;
    const int seg = c0 < C_K ? 0 : C_K, cc = c0 - seg, hm = cc >> 6, bj = (cc & 63) >> 5;
    return seg + (hm >> 2) * 256 + bj * 128 + (hm & 3) * 32;
}
template <int PART>
__device__ __forceinline__ void conv_mixer_weights(KP p, LAS unsigned char* lds) {
    const int lane = threadIdx.x & 63, wv = threadIdx.x >> 6;
    LAS float* scr = (LAS float*)(lds + wv * 16384);
    const int gw = blockIdx.x * NWAVE + wv, ngw = gridDim.x * NWAVE;
    constexpr int I_A = 16 * 32, I_B = 32 * 32, I_O = 16 * 32;
    bf16* WTIN = (bf16*)(p->ws + WS_WTIN); bf16* WTA = (bf16*)(p->ws + WS_WTA); bf16* WTB = (bf16*)(p->ws + WS_WTB); bf16* WTO = (bf16*)(p->ws + WS_WTOUT);
    if constexpr (PART == 0) {
        const bool half = gridDim.x == 256;
        if (half && blockIdx.x < 128) return;
        for (int it = half ? gw - 128 * NWAVE : gw; it < 16 * 160; it += half ? ngw / 2 : ngw) { const int kb = it / 160, nb = 160 + it % 160;
            const TrItem t{p->w_in, (size_t)INW, kb * 64, nb * 32, (bf16*)(p->ws + WS_WTIN8), (size_t)1024, nb * 32 - C_Z}; f32x4 v[8]; transpose_load(t, v, lane); transpose_finish8(t, v, scr, lane, WIN_SCALE); }
    } else if constexpr (PART == 1) {
        for (int it = gw; it < 16 * 160; it += ngw) { const int kb = it / 160, nb = it % 160;
            const TrItem t{p->w_in, (size_t)INW, kb * 64, nb * 32, (bf16*)(p->ws + WS_WTIN), (size_t)1024, win_drow(nb * 32)}; f32x4 v[8]; transpose_load(t, v, lane); transpose_finish8(t, v, scr, lane, WIN_SCALE); }
    } else {
        for (int it = gw; it < I_A + I_B + I_O; it += ngw) {
            int r = it;
            if (r < I_A) { const int kb = r / 32, nb = r % 32; const TrItem t{p->w_branch_a, (size_t)1024, kb * 64, nb * 32, WTA, (size_t)2048, nb * 32}; f32x4 v[8]; transpose_load(t, v, lane); transpose_finish8g(t, v, scr, lane, WM_SCALE, p->subln_g + ((kb * 64) & 127)); continue; } r -= I_A;
            if (r < I_B) { const int kb = r / 32, nb = r % 32; const TrItem t{p->w_branch_b, (size_t)1024, kb * 64, nb * 32, WTB, (size_t)2048, nb * 32}; f32x4 v[8]; transpose_load(t, v, lane); transpose_finish8g<true>(t, v, scr, lane, WM_SCALE, p->ssd_norm_g + kb * 64); continue; } r -= I_B;
            { const int kb = r / 32, nb = r % 32; transpose_item(p->w_out, 1024, kb * 64, nb * 32, WTO, 1024, nb * 32, scr, lane); }
        }
    }
}
struct EpiSsdCols {
    static constexpr bool PERM = true, AFTER_DRAIN = false;
    unsigned char* ws;
    __device__ __forceinline__ void operator()(const f32x4 (&acc)[2][2][4][2], const Unit& u, int wr, int wc, int fr, int fq) const {
        const int row0 = u.pm * BM + wr * 64 + fr; const bool isz = u.pn < 8;
        bf16* base = (bf16*)(ws + (isz ? WS_A : WS_B)); const int ldc = isz ? 2048 : 3072; const int col0 = (isz ? u.pn : u.pn - 8) * BM + wc * 32 + 8 * fq;
#pragma unroll
        for (int ai = 0; ai < 2; ++ai)
#pragma unroll
            for (int m = 0; m < 4; ++m) { bf16* rowp = base + (size_t)(row0 + ai * HALF + m * 16) * ldc + col0;
#pragma unroll
                for (int bj = 0; bj < 2; ++bj) { f32x4 v0 = acc[ai][bj][m][0] * (1.f / WIN_SCALE), v1 = acc[ai][bj][m][1] * (1.f / WIN_SCALE);
                    if (isz) { v0 = silu4(v0); v1 = silu4(v1); }
                    *(v4u*)(rowp + bj * HALF) = pack8(v0, v1); } }
    }
};
struct EpiAttCols {
    static constexpr bool PERM = true, AFTER_DRAIN = false;
    unsigned char* ws; const float* qg; const float* kg; const float* rope; float qscale;
    XcdBarrier bar; bool split; volatile LAS unsigned* pend;
    __device__ __forceinline__ void operator()(const f32x4 (&acc)[2][2][4][2], const Unit& u, int wr, int wc, int fr, int fq) const {
        const int row0 = u.pm * BM + wr * 64 + fr;
        if (split && pend[0] != 0u) { xcd_barrier_wait(bar); if (threadIdx.x == 0) pend[0] = 0u; }
        if (u.pn < 8) {
            const bool isq = u.pn < 4; bf16* base = (bf16*)(ws + (isq ? WS_Q : WS_K)); const float* g = isq ? qg : kg; const float sc = isq ? qscale : 1.f;
            const int hm = 4 * (u.pn & 3) + wc;
            const f32x4 g00 = *(const f32x4*)(g + 8 * fq), g01 = *(const f32x4*)(g + 8 * fq + 4), g10 = *(const f32x4*)(g + 32 + 8 * fq), g11 = *(const f32x4*)(g + 36 + 8 * fq);
            constexpr int W = 2;
            f32x4 rr[8][4];
#define AT_LOAD(i_) do { const f32x4* rp_ = (const f32x4*)(rope + ((size_t)(row0 + ((i_) >> 2) * HALF + ((i_) & 3) * 16) * 32 + 8 * fq) * 2); rr[i_][0] = rp_[0]; rr[i_][1] = rp_[1]; rr[i_][2] = rp_[2]; rr[i_][3] = rp_[3]; } while (0)
#pragma unroll
            for (int i = 0; i < W; ++i) AT_LOAD(i);
#pragma unroll
            for (int gi = 0; gi < 8; ++gi) { const int ai = gi >> 2, m = gi & 3; const int row = row0 + ai * HALF + m * 16;
                    if (gi + W < 8) AT_LOAD(gi + W);
                    f32x4 a00 = acc[ai][0][m][0] * (1.f / WIN_SCALE), a01 = acc[ai][0][m][1] * (1.f / WIN_SCALE), a10 = acc[ai][1][m][0] * (1.f / WIN_SCALE), a11 = acc[ai][1][m][1] * (1.f / WIN_SCALE);
                    const f32x4 q = a00 * a00 + a01 * a01 + a10 * a10 + a11 * a11;
                    float ss = (q[0] + q[1]) + (q[2] + q[3]);
                    ss += __shfl_xor(ss, 16); ss += __shfl_xor(ss, 32);
                    const float r = __builtin_amdgcn_rsqf(ss * (1.f / 64.f) + EPS);
                    a00 = a00 * r * g00; a01 = a01 * r * g01; a10 = a10 * r * g10; a11 = a11 * r * g11;
                    const f32x4 r0 = rr[gi][0], r1 = rr[gi][1], r2 = rr[gi][2], r3 = rr[gi][3];
                    const f32x4 c0 = {r0[0], r0[2], r1[0], r1[2]}, s0 = {r0[1], r0[3], r1[1], r1[3]}, c1 = {r2[0], r2[2], r3[0], r3[2]}, s1 = {r2[1], r2[3], r3[1], r3[3]};
                    const f32x4 o00 = (a00 * c0 - a10 * s0) * sc, o01 = (a01 * c1 - a11 * s1) * sc, o10 = (a10 * c0 + a00 * s0) * sc, o11 = (a11 * c1 + a01 * s1) * sc;
                    bf16* rowp = base + (size_t)row * 1024 + hm * 64 + 8 * fq;
                    *(v4u*)rowp = pack8(o00, o01); *(v4u*)(rowp + 32) = pack8(o10, o11); }
#undef AT_LOAD
        } else {
            const int seg = (u.pn - 8) >> 2; bf16* base = (bf16*)(ws + (seg == 0 ? WS_V : (seg == 1 ? WS_GA : WS_GB))); const int col0 = ((u.pn - 8) & 3) * BM + wc * 32 + 8 * fq;
#pragma unroll
            for (int ai = 0; ai < 2; ++ai)
#pragma unroll
                for (int m = 0; m < 4; ++m) { bf16* rowp = base + (size_t)(row0 + ai * HALF + m * 16) * 1024 + col0;
#pragma unroll
                    for (int bj = 0; bj < 2; ++bj) { f32x4 v0 = acc[ai][bj][m][0] * (1.f / WIN_SCALE), v1 = acc[ai][bj][m][1] * (1.f / WIN_SCALE);
                        if (seg != 0) { v0 = den4(v0); v1 = den4(v1); }
                        *(v4u*)(rowp + bj * HALF) = pack8(v0, v1); } }
        }
    }
};
struct EpiGateB {
    static constexpr bool PERM = true, AFTER_DRAIN = false;
    bf16* TMP; const bf16* GB; float sc; XcdBarrier bar; bool split; volatile LAS unsigned* pend;
    __device__ __forceinline__ void operator()(const f32x4 (&acc)[2][2][4][2], const Unit& u, int wr, int wc, int fr, int fq) const {
        const int row0 = u.pm * BM + wr * 64 + fr, col0 = u.pn * BM + wc * 32 + 8 * fq;
        if (split && pend[0] != 0u) { xcd_barrier_wait(bar); if (threadIdx.x == 0) pend[0] = 0u; }
        constexpr int W = 8;
        v4u gb[16];
#define MG_OFF(i_) ((size_t)(row0 + ((i_) >> 3) * HALF + (((i_) >> 1) & 3) * 16) * 1024 + col0 + ((i_) & 1) * HALF)
#pragma unroll
        for (int i = 0; i < W; ++i) gb[i] = __builtin_nontemporal_load((const v4u*)(GB + MG_OFF(i)));
#pragma unroll
        for (int i = 0; i < 16; ++i) { if (i + W < 16) gb[i + W] = __builtin_nontemporal_load((const v4u*)(GB + MG_OFF(i + W)));
            *(v4u*)(TMP + MG_OFF(i)) = pack8(up_lo(gb[i]) * sc * acc[i >> 3][i & 1][(i >> 1) & 3][0], up_hi(gb[i]) * sc * acc[i >> 3][i & 1][(i >> 1) & 3][1]); }
#undef MG_OFF
    }
};
struct EpiMergeA {
    static constexpr bool PERM = true, AFTER_DRAIN = false;
    bf16* MG; const bf16 *GA, *TMP; float sc;
    __device__ __forceinline__ void operator()(const f32x4 (&acc)[2][2][4][2], const Unit& u, int wr, int wc, int fr, int fq) const {
        const int row0 = u.pm * BM + wr * 64 + fr, col0 = u.pn * BM + wc * 32 + 8 * fq;
        constexpr int W = 6;
        v4u ga[16], tm[16];
#define MG_OFF(i_) ((size_t)(row0 + ((i_) >> 3) * HALF + (((i_) >> 1) & 3) * 16) * 1024 + col0 + ((i_) & 1) * HALF)
#define MG_LOAD(i_) do { const size_t o_ = MG_OFF(i_); ga[i_] = __builtin_nontemporal_load((const v4u*)(GA + o_)); tm[i_] = *(const v4u*)(TMP + o_); } while (0)
#pragma unroll
        for (int i = 0; i < W; ++i) MG_LOAD(i);
#pragma unroll
        for (int i = 0; i < 16; ++i) { if (i + W < 16) MG_LOAD(i + W);
            const f32x4 a0 = acc[i >> 3][i & 1][(i >> 1) & 3][0], a1 = acc[i >> 3][i & 1][(i >> 1) & 3][1];
            const f32x4 v0 = up_lo(tm[i]) + up_lo(ga[i]) * sc * a0, v1 = up_hi(tm[i]) + up_hi(ga[i]) * sc * a1;
            *(v4u*)(MG + MG_OFF(i)) = pack8(v0, v1); }
#undef MG_LOAD
#undef MG_OFF
    }
};
struct EpiMergeF {
    static constexpr bool PERM = true, AFTER_DRAIN = false;
    bf16* MG; const bf16 *GA, *GB; float sc; XcdBarrier bar; bool split;
#define MG_OFF(i_) ((size_t)(row0 + ((i_) >> 3) * HALF + (((i_) >> 1) & 3) * 16) * 1024 + col0 + ((i_) & 1) * HALF)
    __device__ __forceinline__ void pre_mid() const { if (split) xcd_barrier_wait(bar); }
    __device__ __forceinline__ void mid(f32x4 (&acc)[2][2][4][2], const Unit& u, int wr, int wc, int fr, int fq) const {
        const int row0 = u.pm * BM + wr * 64 + fr, col0 = u.pn * BM + wc * 32 + 8 * fq;
        asm volatile("s_nop 15\n\ts_nop 15" ::: "memory");
#pragma unroll
        for (int c = 0; c < 8; ++c) { v4u ga[2], gb[2];
            int ob = (row0 + (c >> 2) * HALF + (c & 3) * 16) * 1024 + col0; asm volatile("" : "+v"(ob));
#pragma unroll
            for (int j = 0; j < 2; ++j) { const int o = ob + j * HALF; ga[j] = *(const v4u*)(GA + o); gb[j] = __builtin_nontemporal_load((const v4u*)(GB + o)); }
            __builtin_amdgcn_sched_barrier(0);
#pragma unroll
            for (int j = 0; j < 2; ++j) { const int i = 2 * c + j;
                const f32x4 a0 = up_lo(ga[j]), a1 = up_hi(ga[j]), b0 = up_lo(gb[j]), b1 = up_hi(gb[j]);
                f32x4 r0, r1;
#pragma unroll
                for (int e = 0; e < 4; ++e) { r0[e] = a0[e] * __builtin_amdgcn_rcpf(b0[e]); r1[e] = a1[e] * __builtin_amdgcn_rcpf(b1[e]); }
#pragma unroll
                for (int q = 0; q < 4; ++q) { float x0 = acc[i >> 3][i & 1][(i >> 1) & 3][0][q], x1 = acc[i >> 3][i & 1][(i >> 1) & 3][1][q];
                    asm volatile("v_mul_f32 %0, %0, %1" : "+v"(x0) : "v"(r0[q])); asm volatile("v_mul_f32 %0, %0, %1" : "+v"(x1) : "v"(r1[q]));
                    acc[i >> 3][i & 1][(i >> 1) & 3][0][q] = x0; acc[i >> 3][i & 1][(i >> 1) & 3][1][q] = x1; } }
            __builtin_amdgcn_sched_barrier(0); }
    }
    __device__ __forceinline__ void operator()(const f32x4 (&acc)[2][2][4][2], const Unit& u, int wr, int wc, int fr, int fq) const {
        const int row0 = u.pm * BM + wr * 64 + fr, col0 = u.pn * BM + wc * 32 + 8 * fq;
        constexpr int W = 8;
        v4u ga[16];
#pragma unroll
        for (int i = 0; i < W; ++i) ga[i] = __builtin_nontemporal_load((const v4u*)(GA + MG_OFF(i)));
#pragma unroll
        for (int i = 0; i < 16; ++i) { if (i + W < 16) ga[i + W] = __builtin_nontemporal_load((const v4u*)(GA + MG_OFF(i + W)));
            f32x4 a0 = up_lo(ga[i]), a1 = up_hi(ga[i]);
#pragma unroll
            for (int e = 0; e < 4; ++e) { a0[e] = __builtin_amdgcn_rcpf(a0[e]); a1[e] = __builtin_amdgcn_rcpf(a1[e]); }
            *(v4u*)(MG + MG_OFF(i)) = pack8(a0 * sc * acc[i >> 3][i & 1][(i >> 1) & 3][0], a1 * sc * acc[i >> 3][i & 1][(i >> 1) & 3][1]); }
    }
#undef MG_OFF
};
struct EpiMix {
    static constexpr bool PERM = true, AFTER_DRAIN = false;
    float* X1; const float* x; const float* modv;
    __device__ __forceinline__ void operator()(const f32x4 (&acc)[2][2][4][2], const Unit& u, int wr, int wc, int fr, int fq) const {
        const int row0 = u.pm * BM + wr * 64 + fr, col0 = u.pn * BM + wc * 32 + 8 * fq;
        const float* g1 = modv + ((u.pm * BM) / SEQ) * 6 * DM + 2 * DM + col0;
        f32x4 gv[2][2];
#pragma unroll
        for (int bj = 0; bj < 2; ++bj) { gv[bj][0] = *(const f32x4*)(g1 + bj * HALF); gv[bj][1] = *(const f32x4*)(g1 + bj * HALF + 4); }
        constexpr int W = 6;
        f32x4 xa[16], xb[16];
#define MX_OFF(i_) ((size_t)(row0 + ((i_) >> 3) * HALF + (((i_) >> 1) & 3) * 16) * 1024 + col0 + ((i_) & 1) * HALF)
#define MX_LOAD(i_) do { const size_t o_ = MX_OFF(i_); xa[i_] = __builtin_nontemporal_load((const f32x4*)(x + o_)); xb[i_] = __builtin_nontemporal_load((const f32x4*)(x + o_ + 4)); } while (0)
#pragma unroll
        for (int i = 0; i < W; ++i) MX_LOAD(i);
#pragma unroll
        for (int i = 0; i < 16; ++i) { if (i + W < 16) MX_LOAD(i + W);
            const size_t o = MX_OFF(i);
            *(f32x4*)(X1 + o) = xa[i] + acc[i >> 3][i & 1][(i >> 1) & 3][0] * gv[i & 1][0]; *(f32x4*)(X1 + o + 4) = xb[i] + acc[i >> 3][i & 1][(i >> 1) & 3][1] * gv[i & 1][1]; }
#undef MX_LOAD
#undef MX_OFF
    }
};

template <class Epi>
__device__ __forceinline__ void run_gemm(LAS unsigned char* lds, const bf16* A, const bf16* Bt, int N, int K, const Epi& E) {
    pg8::Gemm g{A, Bt, T, N, K}; pg8::StaticOrder S; S.init(T, N, (int)gridDim.x, (int)blockIdx.x);
    pg8::gemm_phase<Epi, pg8::StaticOrder, true, true>(lds, g, S, E);
}
}
namespace mk {
__device__ __forceinline__ void mod_phase(KP p, LAS unsigned char* L) {
    LAS float* sc = (LAS float*)L;
    LAS float* part = sc + 2048;
    float* modv = (float*)(p->ws + WS_MODV);
    const int tid = threadIdx.x, lane = tid & 63, w = tid >> 6;
    if (blockIdx.x == gridDim.x - 1 && w == 0) {
        const float* lq = p->lambda_qk; const float a = wave_sum(lq[lane] * lq[64 + lane]), bq = wave_sum(lq[128 + lane] * lq[192 + lane]);
        if (lane == 0) modv[2 * 6 * DM] = __expf(a) - __expf(bq) + LAMBDA_INIT; }
    if (blockIdx.x >= 128 && gridDim.x >= 128) return;
    for (int i = tid; i < 2048; i += NTHR) sc[i] = siluf_(p->c[i]);
    __syncthreads();
    for (int blk = blockIdx.x; blk < 128; blk += gridDim.x) {
        const int j = blk * 48 + lane; float a0 = 0.f, a1 = 0.f;
        if (lane < 48) {
#pragma unroll 32
            for (int k = w * 128; k < w * 128 + 128; ++k) { const float wv = __builtin_nontemporal_load(p->w_ada + (size_t)k * 6 * DM + j); a0 += sc[k] * wv; a1 += sc[1024 + k] * wv; }
        }
        part[(w * 2 + 0) * 64 + lane] = a0; part[(w * 2 + 1) * 64 + lane] = a1;
        __syncthreads();
        if (tid < 128) { const int b = tid >> 6; float s = 0.f;
#pragma unroll
            for (int ww = 0; ww < 8; ++ww) s += part[(ww * 2 + b) * 64 + lane];
            if (lane < 48) modv[b * 6 * DM + j] = s + p->b_ada[j]; }
        __syncthreads();
    }
}
__device__ __forceinline__ void rope_phase(KP p) {
    float* rope = (float*)(p->ws + WS_ROPE);
    for (int i = blockIdx.x * NTHR + threadIdx.x; i < T * 32; i += gridDim.x * NTHR) {
        const int t = i >> 5, f = i & 31;
        const float inv = powf(10000.0f, -(float)f / 32.0f);
        const float ang = (float)p->positions[t] * inv;
        float sn, cs; sincosf(ang, &sn, &cs);
        rope[2 * i] = cs; rope[2 * i + 1] = sn;
    }
}
__device__ __forceinline__ void conv_wdt(KP p, LAS unsigned char* lds) {
    const int lane = threadIdx.x & 63, wv = threadIdx.x >> 6, gw = ((int)blockIdx.x - (gridDim.x == 256 ? 128 : 0)) * NWAVE + wv;
    if (gw >= 0 && gw < 16) transpose_item(p->w_in, INW, gw * 64, C_DT, (bf16*)(p->ws + WS_WTDT), 1024, 0, (LAS float*)(lds + wv * 16384), lane);
}
__device__ __forceinline__ void h_dt_phase(KP p, LAS unsigned char* L) {
    unsigned char* ws = p->ws;
    const float* modv = (const float*)(ws + WS_MODV); bf16* H = (bf16*)(ws + WS_H); float* DTP = (float*)(ws + WS_DTP); const bf16* WT = (const bf16*)(ws + WS_WTDT);
    constexpr int WP = 2064;
    const int tid = threadIdx.x, lane = tid & 63, w = tid >> 6, r = lane & 15, q = lane >> 4;
    for (int i = tid; i < 32 * 128; i += NTHR) { const int n = i >> 7, c16 = i & 127; *(LAS v4u*)(L + n * WP + c16 * 16) = *(const v4u*)(WT + n * 1024 + c16 * 8); }
    LAS float* GT = (LAS float*)(L + 69632);
    for (int i = tid; i < 2 * 1024; i += NTHR) { const int bb = i >> 10, k = i & 1023; GT[bb * 2048 + k] = p->norm1_g[k] * (1.f + modv[bb * 6 * DM + DM + k]); GT[bb * 2048 + 1024 + k] = modv[bb * 6 * DM + k]; }
    __syncthreads();
    const int gw = blockIdx.x * NWAVE + w, ngw = gridDim.x * NWAVE;
    for (int grp = gw; grp < T / 8; grp += ngw) {
        const int row = grp * 8 + (r & 7), b = row / SEQ; const bool own = r < 8;
        const float* xr = p->x + (size_t)row * DM + 8 * q;
        float ss = 0.f;
#pragma unroll 16
        for (int ks = 0; ks < 32; ++ks) { const f32x4 a = *(const f32x4*)(xr + 32 * ks), c = *(const f32x4*)(xr + 32 * ks + 4); const f32x4 s2 = a * a + c * c; ss += (s2[0] + s2[1]) + (s2[2] + s2[3]); }
        ss += __shfl_xor(ss, 16); ss += __shfl_xor(ss, 32);
        const float rs = rsqrtf(ss * (1.f / DM) + EPS);
        const LAS float* gt = GT + b * 2048 + 8 * q;
        f32x4 d0 = {0.f, 0.f, 0.f, 0.f}, d1 = {0.f, 0.f, 0.f, 0.f};
        asm volatile("" : "+v"(d0), "+v"(d1));
        bf16* hr = H + (size_t)row * DM + 8 * q; unsigned char* h8r = ws + WS_H8 + (size_t)row * DM + 8 * q;
        f32x4 xa[2][8], xc[2][8];
#define HD_LOAD(ch_) do { _Pragma("unroll") for (int i = 0; i < 8; ++i) { xa[(ch_) & 1][i] = *(const f32x4*)(xr + 32 * (8 * (ch_) + i)); xc[(ch_) & 1][i] = *(const f32x4*)(xr + 32 * (8 * (ch_) + i) + 4); } } while (0)
        HD_LOAD(0);
#pragma unroll
        for (int ch = 0; ch < 4; ++ch) {
            if (ch < 3) HD_LOAD(ch + 1);
#pragma unroll
            for (int i = 0; i < 8; ++i) { const int ks = 8 * ch + i;
                const f32x4 g0 = *(const LAS f32x4*)(gt + 32 * ks), g1 = *(const LAS f32x4*)(gt + 32 * ks + 4), h0 = *(const LAS f32x4*)(gt + 1024 + 32 * ks), h1 = *(const LAS f32x4*)(gt + 1024 + 32 * ks + 4);
                const f32x4 u0 = xa[ch & 1][i] * rs * g0 + h0, u1 = xc[ch & 1][i] * rs * g1 + h1;
                const v4u hw = pack8(u0, u1);
                if (own) { v2u h8; h8.x = pk4_fp8(clamp8(u0[0]), clamp8(u0[1]), clamp8(u0[2]), clamp8(u0[3])); h8.y = pk4_fp8(clamp8(u1[0]), clamp8(u1[1]), clamp8(u1[2]), clamp8(u1[3])); *(v2u*)(h8r + 32 * ks) = h8; }
                const bf16x8 hf = __builtin_bit_cast(bf16x8, hw);
                const bf16x8 w0 = *(const LAS bf16x8*)(L + r * WP + (32 * ks + 8 * q) * 2), w1 = *(const LAS bf16x8*)(L + (16 + r) * WP + (32 * ks + 8 * q) * 2);
                d0 = __builtin_amdgcn_mfma_f32_16x16x32_bf16(w0, hf, d0, 0, 0, 0); d1 = __builtin_amdgcn_mfma_f32_16x16x32_bf16(w1, hf, d1, 0, 0, 0); }
        }
#undef HD_LOAD
        const f32x4 b0 = *(const f32x4*)(p->dt_bias + 4 * q), b1 = *(const f32x4*)(p->dt_bias + 16 + 4 * q);
        f32x4 o0, o1;
#pragma unroll
        for (int i = 0; i < 4; ++i) { o0[i] = softplusf_(d0[i] + b0[i]); o1[i] = softplusf_(d1[i] + b1[i]); }
        if (own) { *(f32x4*)(DTP + (size_t)row * 32 + 4 * q) = o0; *(f32x4*)(DTP + (size_t)row * 32 + 16 + 4 * q) = o1; }
    }
}
}
namespace mk {
__device__ __forceinline__ void attn_phase(KP p, unsigned char* lds) {
    unsigned char* ws = p->ws;
    const bf16* Q = (const bf16*)(ws + WS_Q); const bf16* K = (const bf16*)(ws + WS_K); const bf16* V = (const bf16*)(ws + WS_V);
    bf16* SCR = (bf16*)(ws + WS_D) + (size_t)blockIdx.x * 65536;
    unsigned char* YA = ws + WS_YA8;
    const int G = gridDim.x, bx = blockIdx.x, vcu = (G % 8 == 0) ? (bx % 8) * (G / 8) + bx / 8 : bx;
    for (int j = vcu * 4; j < 256 * 4; j += (j & 3) == 3 ? (G - 1) * 4 + 1 : 1) {
        const int v = j >> 2, i = (j >> 1) & 1, m = j & 1, bh = v >> 4, s = v & 15, qb = i ? 31 - s : s, b = bh >> 3, h = bh & 7;
        attn_body::attn_unit<8>(b, h * 2 + m, qb, h * 128, Q, K, V, SCR + m * 128, 256, (char*)lds);
        if (m == 1) {
            asm volatile("s_waitcnt vmcnt(0)" ::: "memory"); __syncthreads();
            const int tid = threadIdx.x, row = tid >> 1, half = tid & 1;
            const float lam = ((const float*)(ws + WS_MODV))[2 * 6 * DM];
            const v4u* s0 = (const v4u*)(SCR + row * 256 + half * 64); const v4u* s1 = (const v4u*)(SCR + row * 256 + 128 + half * 64);
            float ss = 0.f;
            unsigned char* yo = YA + (size_t)(b * SEQ + qb * 256 + row) * 2048   + h * 128 + half * 64;
            v4u av[8], bv[8];
#pragma unroll
            for (int c = 0; c < 8; ++c) { av[c] = s0[c]; bv[c] = s1[c]; }
#pragma unroll
            for (int c = 0; c < 8; ++c) { const f32x4 d0 = up_lo(av[c]) - lam * up_lo(bv[c]), d1 = up_hi(av[c]) - lam * up_hi(bv[c]); const f32x4 q = d0 * d0 + d1 * d1; ss += (q[0] + q[1]) + (q[2] + q[3]); }
            ss += __shfl_xor(ss, 1);
            const float rr = __builtin_amdgcn_rsqf(ss * (1.f / 128.f) + EPS) * ((1.f - LAMBDA_INIT) * YA_SCALE);
#pragma unroll
            for (int c = 0; c < 8; ++c) { const f32x4 d0 = (up_lo(av[c]) - lam * up_lo(bv[c])) * rr, d1 = (up_hi(av[c]) - lam * up_hi(bv[c])) * rr;
                v2u o8; o8.x = pk4_fp8(d0[0], d0[1], d0[2], d0[3]); o8.y = pk4_fp8(d1[0], d1[1], d1[2], d1[3]); *(v2u*)(yo + 8 * c) = o8; }
            __syncthreads();
        }
    }
}
}
namespace mk {
constexpr int LM_OFF = 131072;
constexpr int CW_ECNT = 8192;
constexpr float Y_SCALE = 32.f;

__device__ __forceinline__ void moe_tables(KP p, LAS unsigned char* L) {
    LAS int* cnts = (LAS int*)(L + LM_OFF); LAS int* tstart = cnts + 64;
    const int tid = threadIdx.x;
    __syncthreads();
    if (tid < 64) {
        const int c = (int)__hip_atomic_load((unsigned*)(p->ws + WS_CTL) + CW_ECNT + tid * 32, __ATOMIC_RELAXED, __HIP_MEMORY_SCOPE_AGENT);
        cnts[tid] = c; int incl = (c + 255) >> 8;
#pragma unroll
        for (int o = 1; o < 64; o <<= 1) { const int n = __shfl_up(incl, o); if (tid >= o) incl += n; }
        tstart[tid + 1] = incl; if (tid == 0) tstart[0] = 0; if (tid == 63) tstart[65] = incl + 64;
    }
    __syncthreads();
    LAS unsigned char* texp = (LAS unsigned char*)(tstart + 66);
    for (int t = tid; t < 640; t += NTHR) { int lo = 0, hi = 64;
#pragma unroll
        for (int it = 0; it < 7; ++it) { const int mid = (lo + hi + 1) >> 1; if (mid <= 64 && tstart[mid] <= t) lo = mid; else hi = mid - 1; }
        texp[t] = (unsigned char)lo; }
    __syncthreads();
}
__device__ __forceinline__ int find_expert(const LAS int* tstart, int tile) { return (int)((const LAS unsigned char*)(tstart + 66))[tile]; }

struct EpiAct {
    static constexpr bool PERM = true, AFTER_DRAIN = false;
    unsigned char* ws; const LAS int* cnts; const LAS int* tstart;
    __device__ __forceinline__ void operator()(const f32x4 (&acc)[2][2][4][2], const Unit& u, int wr, int wc, int fr, int fq) const {
        const int e = u.pn >> 1, h = u.pn & 1, j0 = (u.pm - tstart[e]) * 256, cnt = e < 64 ? cnts[e] : T;
        int fr0 = fr; asm volatile("" : "+v"(fr0)); fr = fr0;
        const float* lw = (const float*)(ws + WS_LW) + (size_t)(e & 63) * 16384;
        unsigned char* ACT = ws + WS_ACT;
        float wv[8];
#pragma unroll
        for (int i = 0; i < 8; ++i) { const int pos = j0 + (i >> 2) * HALF + wr * 64 + (i & 3) * 16 + fr; wv[i] = lw[pos < cnt ? pos : 0]; }
#pragma unroll
        for (int ai = 0; ai < 2; ++ai)
#pragma unroll
            for (int m = 0; m < 4; ++m) { const int r = ai * HALF + wr * 64 + m * 16 + fr, pos = j0 + r;
                const float w = pos < cnt ? (e < 64 ? wv[ai * 4 + m] : 1.f) : 0.f;
                const float ws_ = w * (1.f / WGU_SCALE);
                const f32x4 v0 = silu4(acc[ai][0][m][0] * (1.f / WGU_SCALE)) * acc[ai][1][m][0] * ws_, v1 = silu4(acc[ai][0][m][1] * (1.f / WGU_SCALE)) * acc[ai][1][m][1] * ws_;
                { const f32x4 s0_ = v0 * ACT_SCALE, s1_ = v1 * ACT_SCALE; v2u o; o.x = pk4_fp8(clamp8(s0_[0]), clamp8(s0_[1]), clamp8(s0_[2]), clamp8(s0_[3])); o.y = pk4_fp8(clamp8(s1_[0]), clamp8(s1_[1]), clamp8(s1_[2]), clamp8(s1_[3]));
                  *(v2u*)(ACT + ((size_t)u.pm * 256 + r) * 256 + h * 128 + wc * 32 + 8 * fq) = o; } }
    }
};
struct MoeUpOrder {
    const LAS int* tstart; int vcu, G, U;
    __device__ __forceinline__ bool next(int i, Unit& u) const { const int ui = i * G + vcu; if (ui >= U) return false; const int tile = ui >> 1; u.pm = tile; u.pn = find_expert(tstart, tile) * 2 + (ui & 1); return true; }
    __device__ __forceinline__ void a_ready(const Unit&) const {}
    __device__ __forceinline__ void done(const Unit&) const {}
};
__device__ __forceinline__ void moe_up_phase(KP p, LAS unsigned char* L) {
    unsigned char* ws = p->ws;
    moe_tables(p, L);
    const LAS int* cnts = (const LAS int*)(L + LM_OFF); const LAS int* tstart = cnts + 64;
    LAS int* tokl = (LAS int*)(L + LM_OFF + 2048);
    const int G = gridDim.x, bx = blockIdx.x, vcu = (G % 8 == 0) ? (bx % 8) * (G / 8) + bx / 8 : bx, tid = threadIdx.x;
    const int* lists = (const int*)(ws + WS_LISTS);
    const int U = tstart[65] * 2;
    { int raw[4], alt[4]; bool val[4], rt[4];
#pragma unroll
      for (int n = 0; n < 4; ++n) { const int k = tid + NTHR * n, i = k >> 8, row = k & 255, ui = i * G + vcu; val[n] = ui < U;
          const int tile = val[n] ? ui >> 1 : 0, e = find_expert(tstart, tile), j0 = (tile - tstart[e]) * 256, cnt = e < 64 ? cnts[e] : T;
          rt[n] = e < 64 && j0 + row < cnt; alt[n] = e < 64 ? 0 : j0 + row;
          raw[n] = lists[rt[n] ? e * 16384 + j0 + row : 0]; }
#pragma unroll
      for (int n = 0; n < 4; ++n) if (val[n]) tokl[tid + NTHR * n] = rt[n] ? raw[n] >> 3 : alt[n]; }
    __syncthreads();
    MoeUpOrder S{tstart, vcu, G, U < 8 * G ? U : 8 * G};
    EpiAct E{ws, cnts, tstart};
    pg8::Gemm g{(const bf16*)(ws + WS_H2), (const bf16*)(ws + WS_WTGU), T, 65 * 512, 512};
    pg8::gemm_phase_gather<EpiAct, MoeUpOrder, true>(L, g, S, E, tokl);
}

struct MoeDownOrder {
    const LAS int* tstart; int vcu, G, U;
    __device__ __forceinline__ bool next(int i, Unit& u) const { const int ui = i * G + vcu; if (ui >= U) return false; const int tile = ui >> 2; u.pm = tile; u.pn = find_expert(tstart, tile) * 4 + (ui & 3); return true; }
    __device__ __forceinline__ void a_ready(const Unit&) const {}
    __device__ __forceinline__ void done(const Unit&) const {}
};
struct EpiDown {
    static constexpr bool PERM = true, AFTER_DRAIN = false;
    unsigned char* ws; const LAS int* cnts; const LAS int* tstart; const LAS int* pairl; int vcu, G;
    __device__ __forceinline__ void operator()(const f32x4 (&acc)[2][2][4][2], const Unit& u, int wr, int wc, int fr, int fq) const {
        int fr0 = fr, fq0 = fq; asm volatile("" : "+v"(fr0), "+v"(fq0)); fr = fr0; fq = fq0;
        const int e = u.pn >> 2, col0 = (u.pn & 3) * 256 + wc * 64 + 16 * fq, j0 = (u.pm - tstart[e]) * 256;
        { unsigned char* Y = ws + (e < 64 ? WS_Y : WS_SH);
            const LAS int* pl = pairl + ((u.pm * 4 + (u.pn & 3) - vcu) / G) * 256;
            int prv[8];
#pragma unroll
            for (int i = 0; i < 8; ++i) prv[i] = pl[(i >> 2) * HALF + wr * 64 + (i & 3) * 16 + fr];
#pragma unroll
            for (int ai = 0; ai < 2; ++ai)
#pragma unroll
                for (int m = 0; m < 4; ++m) { const int pr = prv[ai * 4 + m];
                    if (pr >= 0) { unsigned char* yrow = Y + (size_t)pr * 1024 + col0;
                        unsigned o4[4];
#pragma unroll
                        for (int bj = 0; bj < 2; ++bj) { const f32x4 a = acc[ai][bj][m][0] * (Y_SCALE / (ACT_SCALE * WD_SCALE)), b = acc[ai][bj][m][1] * (Y_SCALE / (ACT_SCALE * WD_SCALE));
                            o4[2 * bj] = pk4_fp8(clamp8(a[0]), clamp8(a[1]), clamp8(a[2]), clamp8(a[3])); o4[2 * bj + 1] = pk4_fp8(clamp8(b[0]), clamp8(b[1]), clamp8(b[2]), clamp8(b[3])); }
                        *(v4u*)yrow = (v4u){o4[0], o4[1], o4[2], o4[3]}; } }
        }
    }
};
template <bool SPLIT> __device__ __forceinline__ void moe_down_phase(KP p, LAS unsigned char* L, const XcdBarrier& bar) {
    unsigned char* ws = p->ws;
    moe_tables(p, L);
    const LAS int* cnts = (const LAS int*)(L + LM_OFF); const LAS int* tstart = cnts + 64;
    const int G = gridDim.x, bx = blockIdx.x, vcu = (G % 8 == 0) ? (bx % 8) * (G / 8) + bx / 8 : bx;
    const int U = tstart[65] * 4;
    LAS int* pairl = (LAS int*)(L + LM_OFF + 2048);
    { const int* lists = (const int*)(ws + WS_LISTS); const int tid = threadIdx.x;
      int raw[6], alt[6]; bool val[6], rt[6];
#pragma unroll
      for (int n = 0; n < 6; ++n) { const int k = tid + NTHR * n, i = k >> 8, row = k & 255, ui = i * G + vcu; val[n] = ui < U;
          const int tile = val[n] ? ui >> 2 : 0, e = find_expert(tstart, tile), j0 = (tile - tstart[e]) * 256;
          rt[n] = e < 64 && j0 + row < cnts[e < 64 ? e : 0]; alt[n] = e < 64 ? -1 : j0 + row;
          raw[n] = lists[rt[n] ? e * 16384 + j0 + row : 0]; }
#pragma unroll
      for (int n = 0; n < 6; ++n) if (val[n]) pairl[tid + NTHR * n] = rt[n] ? raw[n] : alt[n];
      __syncthreads(); }
    if (SPLIT) xcd_barrier_wait(bar);
    MoeDownOrder S{tstart, vcu, G, U < 12 * G ? U : 12 * G};
    EpiDown E{ws, cnts, tstart, pairl, vcu, G};
    pg8::Gemm g{(const bf16*)(ws + WS_ACT), (const bf16*)(ws + WS_WTD), 640 * 256, 65 * 1024, 128};
    pg8::gemm_phase<EpiDown, MoeDownOrder, true, true, true>(L, g, S, E);
}

template <bool SPLIT> __device__ __forceinline__ void final_phase(KP p, const XcdBarrier& bar) {
    unsigned char* ws = p->ws;
    const float* modv = (const float*)(ws + WS_MODV); const unsigned char* SH = ws + WS_SH; const unsigned char* Y = ws + WS_Y;
    const int lane = threadIdx.x & 63, gw = blockIdx.x * NWAVE + (threadIdx.x >> 6), ngw = gridDim.x * NWAVE, c0 = 16 * lane;
    f32x4 xn0[4], xn1[4];
#define FP_LOADX(t_) do { const int ta_ = (t_) < T ? (t_) : gw, tb_ = ta_ + ngw < T ? ta_ + ngw : ta_;     \
        _Pragma("unroll") for (int i = 0; i < 4; ++i) { xn0[i] = __builtin_nontemporal_load((const f32x4*)(p->out + (size_t)ta_ * DM + c0 + 4 * i)); xn1[i] = __builtin_nontemporal_load((const f32x4*)(p->out + (size_t)tb_ * DM + c0 + 4 * i)); } } while (0)
    FP_LOADX(gw);
    if (SPLIT) xcd_barrier_wait(bar);
    for (int t = gw; t < T; t += 2 * ngw) {
        const int t1 = t + ngw < T ? t + ngw : t;
        v4u y0[8], y1[8];
#pragma unroll
        for (int s = 0; s < 8; ++s) { y0[s] = __builtin_nontemporal_load((const v4u*)(Y + ((size_t)t * 8 + s) * 1024 + c0)); y1[s] = __builtin_nontemporal_load((const v4u*)(Y + ((size_t)t1 * 8 + s) * 1024 + c0)); }
        const v4u hs0 = __builtin_nontemporal_load((const v4u*)(SH + (size_t)t * DM + c0)), hs1 = __builtin_nontemporal_load((const v4u*)(SH + (size_t)t1 * DM + c0));
        f32x4 x0[4], x1[4], g0[4], g1[4];
#pragma unroll
        for (int i = 0; i < 4; ++i) { x0[i] = xn0[i]; x1[i] = xn1[i];
            g0[i] = *(const f32x4*)(modv + (t / SEQ) * 6 * DM + 5 * DM + c0 + 4 * i); g1[i] = *(const f32x4*)(modv + (t1 / SEQ) * 6 * DM + 5 * DM + c0 + 4 * i); }
        FP_LOADX(t + 2 * ngw);
        f32x4 a0[4], a1[4];
#pragma unroll
        for (int i = 0; i < 4; ++i) { a0[i] = (f32x4){0.f, 0.f, 0.f, 0.f}; a1[i] = (f32x4){0.f, 0.f, 0.f, 0.f}; }
#pragma unroll
        for (int s = 0; s < 8; ++s)
#pragma unroll
            for (int i = 0; i < 4; ++i) { const int w0 = (int)(i == 0 ? y0[s].x : (i == 1 ? y0[s].y : (i == 2 ? y0[s].z : y0[s].w))), w1 = (int)(i == 0 ? y1[s].x : (i == 1 ? y1[s].y : (i == 2 ? y1[s].z : y1[s].w)));
                const f32x2 l0 = __builtin_amdgcn_cvt_pk_f32_fp8(w0, false), u0 = __builtin_amdgcn_cvt_pk_f32_fp8(w0, true), l1 = __builtin_amdgcn_cvt_pk_f32_fp8(w1, false), u1 = __builtin_amdgcn_cvt_pk_f32_fp8(w1, true);
                a0[i] += (f32x4){l0.x, l0.y, u0.x, u0.y}; a1[i] += (f32x4){l1.x, l1.y, u1.x, u1.y}; }
#pragma unroll
        for (int i = 0; i < 4; ++i) { const int w0 = (int)(i == 0 ? hs0.x : (i == 1 ? hs0.y : (i == 2 ? hs0.z : hs0.w))), w1 = (int)(i == 0 ? hs1.x : (i == 1 ? hs1.y : (i == 2 ? hs1.z : hs1.w)));
            const f32x2 l0 = __builtin_amdgcn_cvt_pk_f32_fp8(w0, false), u0 = __builtin_amdgcn_cvt_pk_f32_fp8(w0, true), l1 = __builtin_amdgcn_cvt_pk_f32_fp8(w1, false), u1 = __builtin_amdgcn_cvt_pk_f32_fp8(w1, true);
            a0[i] += (f32x4){l0.x, l0.y, u0.x, u0.y}; a1[i] += (f32x4){l1.x, l1.y, u1.x, u1.y}; }
#pragma unroll
        for (int i = 0; i < 4; ++i) { *(f32x4*)(p->out + (size_t)t * DM + c0 + 4 * i) = x0[i] + g0[i] * (a0[i] * (1.f / Y_SCALE));
            *(f32x4*)(p->out + (size_t)t1 * DM + c0 + 4 * i) = x1[i] + g1[i] * (a1[i] * (1.f / Y_SCALE)); }
    }
}
#undef FP_LOADX
}
namespace mk {
constexpr size_t WS_WRH = 22 * MiB + 256 * 1024, WS_WRL = 22 * MiB + 512 * 1024;
constexpr int CW_QCONV = 24;
__device__ __forceinline__ void conv_router(KP p, LAS unsigned char* lds) {
    const int lane = threadIdx.x & 63, wv = threadIdx.x >> 6, gw = ((int)blockIdx.x - (gridDim.x == 256 ? 128 : 0)) * NWAVE + wv;
    if (gw < 16 || gw >= 48) return;
    const int it = gw - 16, k0 = (it >> 1) * 64, n0 = (it & 1) * 32;
    LAS float* scr = (LAS float*)(lds + wv * 16384);
    bf16* WH = (bf16*)(p->ws + WS_WRH);
#pragma unroll 8
    for (int i = 0; i < 32; ++i) { const int kk = 2 * i + (lane >> 5); scr[kk * 33 + (lane & 31)] = p->w_router[(size_t)(k0 + kk) * 64 + n0 + (lane & 31)]; }
    asm volatile("s_waitcnt lgkmcnt(0)" ::: "memory");
    const int c = lane & 7;
#pragma unroll
    for (int j = 0; j < 4; ++j) { const int n = (lane >> 3) + 8 * j; const LAS float* s = scr + (8 * c) * 33 + n;
        float v[8]; unsigned h[8];
#pragma unroll
        for (int e = 0; e < 8; ++e) { v[e] = s[e * 33]; h[e] = f2bf(v[e]); }
        v4u oh, ol; oh.x = h[0] | (h[1] << 16); oh.y = h[2] | (h[3] << 16); oh.z = h[4] | (h[5] << 16); oh.w = h[6] | (h[7] << 16);
        ol.x = pk2(v[0] - bf2f(h[0]), v[1] - bf2f(h[1])); ol.y = pk2(v[2] - bf2f(h[2]), v[3] - bf2f(h[3])); ol.z = pk2(v[4] - bf2f(h[4]), v[5] - bf2f(h[5])); ol.w = pk2(v[6] - bf2f(h[6]), v[7] - bf2f(h[7]));
        const int kk = k0 + 8 * c, nn = n0 + n;
        bf16* fp = WH + (size_t)(((((kk >> 7) * 4 + ((kk >> 5) & 3)) * 4 + (nn >> 4)) * 2) * 64 + ((kk >> 3) & 3) * 16 + (nn & 15)) * 8;
        *(v4u*)fp = oh; *(v4u*)(fp + 512) = ol; }
}

__device__ __forceinline__ TrItem expert_item(KP p, int it) {
    const int e = it / 384, rr = it % 384;
    if (rr < 256) { const bool up = rr >= 128; const int qq = rr & 127, kb = qq >> 3, nb = qq & 7, f0 = nb * 32;
        const float* W = e < 64 ? (up ? p->w_exp_up : p->w_exp_gate) + (size_t)e * DM * EDIM : (up ? p->w_sh_up : p->w_sh_gate);
        return TrItem{W, (size_t)EDIM, kb * 64, f0, (bf16*)(p->ws + WS_WTGU + (size_t)e * 512 * 1024), (size_t)1024, 256 * (f0 >> 7) + (up ? 128 : 0) + (f0 & 127)}; }
    const int qq = rr - 256, kb = qq >> 5, nb = qq & 31;
    const float* W = e < 64 ? p->w_exp_down + (size_t)e * EDIM * DM : p->w_sh_down;
    return TrItem{W, (size_t)DM, kb * 64, nb * 32, (bf16*)(p->ws + WS_WTD + (size_t)e * 1024 * 256), (size_t)256, nb * 32};
}
__device__ __forceinline__ void expert_finish(KP p, int it, const f32x4 (&v)[8], LAS float* scr, int lane) {
    transpose_finish8(expert_item(p, it), v, scr, lane, (it % 384) < 256 ? WGU_SCALE : WD_SCALE, (it % 384) >= 256);
}
__device__ __forceinline__ int early_item(int g) { return (g >> 8) * 384 + (g & 255); }
__device__ __forceinline__ int rt_item(int k) { k = k < 16383 ? k : 16383; return k < 8192 ? ((8192 + k) >> 8) * 384 + ((8192 + k) & 255) : ((k - 8192) >> 7) * 384 + 256 + ((k - 8192) & 127); }
__device__ __forceinline__ void conv_expert_slice(KP p, LAS unsigned char* lds, int base) {
    const int lane = threadIdx.x & 63, wv = threadIdx.x >> 6;
    LAS float* scr = (LAS float*)(lds + wv * 16384);
    const int g0 = base + ((int)blockIdx.x * NWAVE + wv) * 2;
    f32x4 va[8], vb[8];
    __syncthreads();
    transpose_load(expert_item(p, early_item(g0)), va, lane); transpose_load(expert_item(p, early_item(g0 + 1)), vb, lane);
    transpose_finish8(expert_item(p, early_item(g0)), va, scr, lane, WGU_SCALE); transpose_finish8(expert_item(p, early_item(g0 + 1)), vb, scr, lane, WGU_SCALE);
}
constexpr int RT_NCONV = 24576;
#define RT_DPP(v_, ctrl_) __builtin_bit_cast(float, __builtin_amdgcn_update_dpp(__builtin_bit_cast(int, v_), __builtin_bit_cast(int, v_), ctrl_, 0xF, 0xF, false))
__device__ __forceinline__ float gmax8(float v) {
    v = fmaxf(v, RT_DPP(v, 0xB1)); v = fmaxf(v, RT_DPP(v, 0x4E)); v = fmaxf(v, RT_DPP(v, 0x141)); return v; }
__device__ __forceinline__ float wmax64(float v) {
    v = gmax8(v); v = fmaxf(v, RT_DPP(v, 0x140));
    v = fmaxf(v, __builtin_bit_cast(float, __builtin_amdgcn_update_dpp(__builtin_bit_cast(int, v), __builtin_bit_cast(int, v), 0x142, 0xA, 0xF, false)));
    v = fmaxf(v, __builtin_bit_cast(float, __builtin_amdgcn_update_dpp(__builtin_bit_cast(int, v), __builtin_bit_cast(int, v), 0x143, 0xC, 0xF, false)));
    return __builtin_bit_cast(float, __builtin_amdgcn_readlane(__builtin_bit_cast(int, v), 63)); }
__device__ __forceinline__ float wsum64(float v) {
    v += RT_DPP(v, 0xB1); v += RT_DPP(v, 0x4E); v += RT_DPP(v, 0x141); v += RT_DPP(v, 0x140);
    v += __builtin_bit_cast(float, __builtin_amdgcn_update_dpp(0, __builtin_bit_cast(int, v), 0x142, 0xA, 0xF, false));
    v += __builtin_bit_cast(float, __builtin_amdgcn_update_dpp(0, __builtin_bit_cast(int, v), 0x143, 0xC, 0xF, false));
    return __builtin_bit_cast(float, __builtin_amdgcn_readlane(__builtin_bit_cast(int, v), 63)); }
template <bool CONV> __device__ __forceinline__ void route_phase3(KP p, LAS unsigned char* L) {
    unsigned char* ws = p->ws;
    int tid_ = threadIdx.x; asm volatile("" : "+v"(tid_));
    const int tid = tid_, lane = tid & 63, w = tid >> 6, r = lane & 15, q = lane >> 4;
    const float* modv = (const float*)(ws + WS_MODV); const float* X1 = p->out; bf16* H2 = (bf16*)(ws + WS_H2);
    const bf16* WH = (const bf16*)(ws + WS_WRH);
    int* lists = (int*)(ws + WS_LISTS); float* lw = (float*)(ws + WS_LW); unsigned* gcnt = (unsigned*)(ws + WS_CTL) + CW_ECNT;
    LAS float* plg = (LAS float*)L;
    LAS float* psum = plg + 8 * 1088;
    LAS unsigned* lcnt = (LAS unsigned*)(L + LM_OFF);
    LAS unsigned* lbase = lcnt + 64;
    LAS unsigned* rec = lbase + 64;
    LAS float* recw = (LAS float*)(rec + 1024);
    const float rb = p->router_bias[lane];
    const int k0 = 128 * w + 8 * q;
    LAS float* cscr = (LAS float*)(L + 40960 + w * 8448);
    f32x4 cv[8];
    LAS float* GT = (LAS float*)(L + 110592);
    bf16x8 wA[8], wB[8];
#define RT_LOADW(buf_, ks_) do { _Pragma("unroll") for (int nb = 0; nb < 4; ++nb) { buf_[2 * nb] = *(const bf16x8*)(whb + ((ks_) * 4 + nb) * 1024); buf_[2 * nb + 1] = *(const bf16x8*)(whb + ((ks_) * 4 + nb) * 1024 + 512); } } while (0)
    __syncthreads();
    if (tid < 64) lcnt[tid] = 0u;
    int nit = 0, tb = -1;
    f32x4 xa[4], xc[4];
#define RT_LOADX(it_) do { int xo_ = r * DM + k0; asm volatile("" : "+v"(xo_)); const size_t ro_ = (size_t)((it_) * 16) * DM + xo_; _Pragma("unroll") for (int ks = 0; ks < 4; ++ks) { xa[ks] = __builtin_nontemporal_load((const f32x4*)(X1 + ro_ + 32 * ks)); xc[ks] = __builtin_nontemporal_load((const f32x4*)(X1 + ro_ + 32 * ks + 4)); } } while (0)
    if ((int)blockIdx.x < T / 16) RT_LOADX((int)blockIdx.x);
    const int wu = __builtin_amdgcn_readfirstlane(w);
    if (CONV) transpose_load(expert_item(p, rt_item((int)blockIdx.x * 64 + wu * 2)), cv, lane);
    for (int it = blockIdx.x; it < T / 16; it += gridDim.x, ++nit) {
        const int row = it * 16 + r, b = (it * 16) / SEQ;
        const int ck = (((int)blockIdx.x * 4 + nit) * 8 + wu) * 2;
        int wofs = w * 16384 + lane * 8; asm volatile("" : "+v"(wofs));
        const bf16* whb = WH + wofs;
        RT_LOADW(wA, 0); RT_LOADW(wB, 1);
        if (b != tb) { tb = b;
            int t2 = 2 * tid; asm volatile("" : "+v"(t2));
            const float* gp = p->norm2_g + t2; const float* scp = modv + b * 6 * DM + 4 * DM + t2; const float* shp = modv + b * 6 * DM + 3 * DM + t2;
            const f32x2 g = *(const f32x2*)gp, s = *(const f32x2*)scp, hh = *(const f32x2*)shp;
            *(LAS f32x2*)(GT + t2) = g * (1.f + s); *(LAS f32x2*)(GT + 1024 + t2) = hh; }
        __builtin_amdgcn_sched_barrier(0);
        float ss = 0.f;
#pragma unroll
        for (int ks = 0; ks < 4; ++ks) {
            const f32x4 s2 = xa[ks] * xa[ks] + xc[ks] * xc[ks]; ss += (s2[0] + s2[1]) + (s2[2] + s2[3]); }
        ss += __shfl_xor(ss, 16); ss += __shfl_xor(ss, 32);
        if (q == 0) psum[w * 16 + r] = ss;
        __syncthreads();
        if (CONV) expert_finish(p, rt_item(ck), cv, cscr, lane);
        float tot = 0.f;
#pragma unroll
        for (int ww = 0; ww < 8; ++ww) tot += psum[ww * 16 + r];
        const float rs = rsqrtf(tot * (1.f / DM) + EPS);
        f32x4 acc[4];
#pragma unroll
        for (int nb = 0; nb < 4; ++nb) { acc[nb] = (f32x4){0.f, 0.f, 0.f, 0.f}; asm volatile("" : "+v"(acc[nb])); }
        unsigned char* hr = (unsigned char*)H2 + (size_t)row * DM + k0;
#pragma unroll
        for (int ks = 0; ks < 4; ++ks) {
            const LAS float* gq = GT + k0 + 32 * ks;
            const f32x4 g0 = *(const LAS f32x4*)gq, g1 = *(const LAS f32x4*)(gq + 4), h0 = *(const LAS f32x4*)(gq + 1024), h1 = *(const LAS f32x4*)(gq + 1028);
            const f32x4 v0 = xa[ks] * rs * g0 + h0, v1 = xc[ks] * rs * g1 + h1;
            const v4u hw = pack8(v0, v1);
            { v2u h8; h8.x = pk4_fp8(clamp8(v0[0]), clamp8(v0[1]), clamp8(v0[2]), clamp8(v0[3])); h8.y = pk4_fp8(clamp8(v1[0]), clamp8(v1[1]), clamp8(v1[2]), clamp8(v1[3])); *(v2u*)(hr + 32 * ks) = h8; }
            const v4u lwv = pack8(v0 - up_lo(hw), v1 - up_hi(hw));
            const bf16x8 hh = __builtin_bit_cast(bf16x8, hw), hl = __builtin_bit_cast(bf16x8, lwv);
#pragma unroll
            for (int nb = 0; nb < 4; ++nb) { const bf16x8 wh = (ks & 1) ? wB[2 * nb] : wA[2 * nb], wl = (ks & 1) ? wB[2 * nb + 1] : wA[2 * nb + 1];
                acc[nb] = __builtin_amdgcn_mfma_f32_16x16x32_bf16(wh, hh, acc[nb], 0, 0, 0);
                acc[nb] = __builtin_amdgcn_mfma_f32_16x16x32_bf16(wl, hh, acc[nb], 0, 0, 0);
                acc[nb] = __builtin_amdgcn_mfma_f32_16x16x32_bf16(wh, hl, acc[nb], 0, 0, 0); }
            __builtin_amdgcn_sched_barrier(0);
            if (ks == 0) { RT_LOADW(wA, 2); __builtin_amdgcn_sched_barrier(0); }
            if (ks == 1) { RT_LOADW(wB, 3); if (CONV) transpose_load(expert_item(p, rt_item(ck + 1)), cv, lane); __builtin_amdgcn_sched_barrier(0); }
        }
#pragma unroll
        for (int nb = 0; nb < 4; ++nb) *(LAS f32x4*)(plg + w * 1088 + r * 68 + 16 * nb + 4 * q) = acc[nb];
        if (it + (int)gridDim.x < T / 16) RT_LOADX(it + (int)gridDim.x);
        __syncthreads();
        if (CONV) { expert_finish(p, rt_item(ck + 1), cv, cscr, lane); transpose_load(expert_item(p, rt_item(ck + 16)), cv, lane); }
        float lgr[2];
#pragma unroll
        for (int i = 0; i < 2; ++i) { float s = 0.f;
#pragma unroll
            for (int ww = 0; ww < 8; ++ww) s += plg[ww * 1088 + (w + 8 * i) * 68 + lane];
            lgr[i] = s; }
#pragma unroll 1
        for (int t2 = 0; t2 < 2; ++t2) {
            const int rr = w + 8 * t2;
            float a = t2 ? lgr[1] : lgr[0];
            a = (a == a) ? fminf(fmaxf(a, -80.f), 80.f) : 0.f;
            const float score = 1.f / (1.f + __expf(-a)), choice = score + rb;
            const float m1 = gmax8(choice);
            const unsigned long long b1 = __ballot(choice == m1);
            const int gfirst = __builtin_ctz((unsigned)(b1 >> (lane & ~7)) & 0xffu);
            const float gsum = m1 + gmax8((lane & 7) == gfirst ? -INFINITY : choice);
            int grank = 0;
#pragma unroll
            for (int i = 0; i < 8; ++i) { const float o = __builtin_bit_cast(float, __builtin_amdgcn_readlane(__builtin_bit_cast(int, gsum), i * 8)); grank += (o > gsum || (o == gsum && i < (lane >> 3))) ? 1 : 0; }
            const bool elig = grank < 4;
            const float v = elig ? choice : -INFINITY;
            unsigned long long selm = 0ull; float vv = v;
#pragma unroll
            for (int k = 0; k < 8; ++k) { const float m = wmax64(vv); const unsigned long long bb = __ballot(vv == m); const int l = __builtin_ctzll(bb); selm |= 1ull << l; if (lane == l) vv = -INFINITY; }
            const bool sel = (selm >> lane) & 1ull;
            const int rank = __builtin_popcountll(selm & ((1ull << lane) - 1ull));
            const float wsum = wsum64(sel ? score : 0.f);
            if (sel) { const unsigned lpos = __hip_atomic_fetch_add(&lcnt[lane], 1u, __ATOMIC_RELAXED, __HIP_MEMORY_SCOPE_WORKGROUP); const int rl = (nit * 16 + rr) * 8 + rank; rec[rl] = (unsigned)lane | (lpos << 8); recw[rl] = score / wsum * ROUTED_SCALE; }
        }
    }
#undef RT_LOADX
#undef RT_LOADW
    __syncthreads();
    if (tid < 64) { const unsigned c = lcnt[tid]; lbase[tid] = c ? __hip_atomic_fetch_add(gcnt + tid * 32, c, __ATOMIC_RELAXED, __HIP_MEMORY_SCOPE_AGENT) : 0u; }
    __syncthreads();
    for (int pi = tid; pi < nit * 128; pi += NTHR) { const unsigned rc = rec[pi]; const int e = rc & 63, pos = (int)(lbase[e] + (rc >> 8));
        const int itn = pi >> 7, token = ((int)blockIdx.x + itn * (int)gridDim.x) * 16 + ((pi >> 3) & 15);
        lists[e * 16384 + pos] = token * 8 + (pi & 7); lw[e * 16384 + pos] = recw[pi]; }
}
__device__ __forceinline__ void conv_expert_weights_q(KP p, LAS unsigned char* lds) {
    const int lane = threadIdx.x & 63, wv = threadIdx.x >> 6;
    LAS float* scr = (LAS float*)(lds + wv * 16384);
    unsigned* head = (unsigned*)(p->ws + WS_CTL) + CW_QCONV;
    constexpr int CH = 12, NIT = 65 * 384;
    __syncthreads();
    for (;;) {
        unsigned itu = 0u; if (lane == 0) itu = __hip_atomic_fetch_add(head, (unsigned)CH, __ATOMIC_RELAXED, __HIP_MEMORY_SCOPE_AGENT);
        const int it0 = (int)__builtin_amdgcn_readfirstlane(itu) + (gridDim.x == 256 ? RT_NCONV : 0);
        if (it0 >= NIT) break;
        f32x4 va[8], vb[8];
        transpose_load(expert_item(p, it0), va, lane);
        for (int it = it0; it < it0 + CH; it += 2) {
            transpose_load(expert_item(p, it + 1), vb, lane);
            expert_finish(p, it, va, scr, lane);
            if (it + 2 < it0 + CH) transpose_load(expert_item(p, it + 2), va, lane);
            expert_finish(p, it + 1, vb, scr, lane);
        }
    }
}
}
namespace ssd {
using mk::cvtpk; using mk::fsig;
constexpr int PITCH = 272;
__device__ __forceinline__ v2u pack4(f32x4 a) { v2u o; o.x = cvtpk(a[0], a[1]); o.y = cvtpk(a[2], a[3]); return o; }
__device__ __forceinline__ f32x4 unpack4(v2u w) { return (f32x4){__builtin_bit_cast(float, w.x << 16), __builtin_bit_cast(float, w.x & 0xffff0000u), __builtin_bit_cast(float, w.y << 16), __builtin_bit_cast(float, w.y & 0xffff0000u)}; }
__device__ __forceinline__ float fsilu(float x) { return x * fsig(x); }
constexpr float LOG2E = 1.4426950408889634f;
__device__ __forceinline__ float fsilu2(float y) { return y * __builtin_amdgcn_rcpf(1.f + __builtin_amdgcn_exp2f(-y)); }
__device__ __forceinline__ f32x4 zero4() { f32x4 z = {0.f, 0.f, 0.f, 0.f}; asm volatile("" : "+v"(z)); return z; }
__device__ __forceinline__ f32x4 mfma16(bf16x8 a, bf16x8 b, f32x4 c) { const f32x4 d = __builtin_amdgcn_mfma_f32_16x16x32_bf16(a, b, c, 0, 0, 0); asm volatile("" :: "v"(a), "v"(b)); return d; }

template <int NCH> struct StageT { unsigned w[NCH / 64][11]; };
template <int NCH>
__device__ __forceinline__ void stage_T_load(const bf16* XBC, int t0, int chg, StageT<NCH>& s) {
    constexpr int NCP = NCH / 2;
    const int tid = threadIdx.x, cp = tid % NCP, ch = chg + 2 * cp;
#pragma unroll
    for (int n = 0; n < NCH / 64; ++n) { const int l0 = ((tid + n * NTHR) / NCP) * 8;
#pragma unroll
        for (int i = 0; i < 11; ++i) s.w[n][i] = *(const unsigned*)(XBC + (long)(t0 + l0 - 3 + i) * CONV_DIM + ch); }
}
template <int NCH, bool SCALE>
__device__ __forceinline__ void stage_T_finish(KP p, bool first, int chg, LAS unsigned char* dst, const LAS float* scale, const StageT<NCH>& s) {
    constexpr int NCP = NCH / 2;
    const int tid = threadIdx.x, cp = tid % NCP, ch = chg + 2 * cp;
    constexpr float TK = LOG2E;
    const float a0 = TK * p->conv_w[ch], a1 = TK * p->conv_w[3072 + ch], a2 = TK * p->conv_w[6144 + ch], a3 = TK * p->conv_w[9216 + ch], ab = TK * p->conv_b[ch];
    const float b0 = TK * p->conv_w[ch + 1], b1 = TK * p->conv_w[3072 + ch + 1], b2 = TK * p->conv_w[6144 + ch + 1], b3 = TK * p->conv_w[9216 + ch + 1], bb = TK * p->conv_b[ch + 1];
#pragma unroll
    for (int n = 0; n < NCH / 64; ++n) {
        const int l0 = ((tid + n * NTHR) / NCP) * 8;
        float ra[11], rb[11];
#pragma unroll
        for (int i = 0; i < 11; ++i) { const unsigned w = (first && l0 - 3 + i < 0) ? 0u : s.w[n][i];
            ra[i] = __builtin_bit_cast(float, w << 16); rb[i] = __builtin_bit_cast(float, w & 0xffff0000u); }
        float oa[8], ob[8];
#pragma unroll
        for (int i = 0; i < 8; ++i) { const float ya = ab + a0 * ra[i] + a1 * ra[i + 1] + a2 * ra[i + 2] + a3 * ra[i + 3], yb = bb + b0 * rb[i] + b1 * rb[i + 1] + b2 * rb[i + 2] + b3 * rb[i + 3];
            oa[i] = fsilu2(ya); ob[i] = fsilu2(yb); }
        if (SCALE) { const LAS float* sc = scale + ((2 * cp) >> 6) * 128 + l0; const f32x4 s0 = *(const LAS f32x4*)sc, s1 = *(const LAS f32x4*)(sc + 4);
#pragma unroll
            for (int i = 0; i < 4; ++i) { oa[i] *= s0[i]; ob[i] *= s0[i]; oa[4 + i] *= s1[i]; ob[4 + i] *= s1[i]; } }
        v4u wa, wb; wa.x = cvtpk(oa[0], oa[1]); wa.y = cvtpk(oa[2], oa[3]); wa.z = cvtpk(oa[4], oa[5]); wa.w = cvtpk(oa[6], oa[7]);
        wb.x = cvtpk(ob[0], ob[1]); wb.y = cvtpk(ob[2], ob[3]); wb.z = cvtpk(ob[4], ob[5]); wb.w = cvtpk(ob[6], ob[7]);
        *(LAS v4u*)(dst + (2 * cp) * PITCH + l0 * 2) = wa; *(LAS v4u*)(dst + (2 * cp + 1) * PITCH + l0 * 2) = wb;
    }
}
__device__ __forceinline__ void stage_N(KP p, const bf16* XBC, int t0, bool first, int chg, LAS unsigned char* dst) {
    const int tid = threadIdx.x, cq = tid & 15, ch = chg + 8 * cq;
    f32x4 w[4][2], bs[2];
#pragma unroll
    for (int j = 0; j < 4; ++j) { w[j][0] = *(const f32x4*)(p->conv_w + j * CONV_DIM + ch); w[j][1] = *(const f32x4*)(p->conv_w + j * CONV_DIM + ch + 4); }
    bs[0] = *(const f32x4*)(p->conv_b + ch); bs[1] = *(const f32x4*)(p->conv_b + ch + 4);
    v4u raw[4][4];
#pragma unroll
    for (int it = 0; it < 4; ++it)
#pragma unroll
        for (int j = 0; j < 4; ++j) raw[it][j] = *(const v4u*)(XBC + (long)(t0 + (tid >> 4) + 32 * it - 3 + j) * CONV_DIM + ch);
#pragma unroll
    for (int it = 0; it < 4; ++it) { const int l = (tid >> 4) + 32 * it;
        f32x4 o0 = bs[0], o1 = bs[1];
#pragma unroll
        for (int j = 0; j < 4; ++j) { const bool off = first && (l - 3 + j < 0); const v4u rw = off ? (v4u){0u, 0u, 0u, 0u} : raw[it][j];
            o0 += w[j][0] * mk::up_lo(rw); o1 += w[j][1] * mk::up_hi(rw); }
        o0 = mk::silu4(o0); o1 = mk::silu4(o1);
        *(LAS v4u*)(dst + l * PITCH + cq * 16) = mk::pack8(o0, o1); }
}
__device__ __forceinline__ void acum_setup(KP p, const float* DTP, int t0, int g, LAS float* s_acum, LAS float* s_dt) {
    const int lane = threadIdx.x & 63, w = threadIdx.x >> 6;
    const float A = -__expf(p->a_log[g * 8 + w]);
    const float d0 = DTP[(size_t)(t0 + 2 * lane) * 32 + g * 8 + w], d1 = DTP[(size_t)(t0 + 2 * lane + 1) * 32 + g * 8 + w];
    const float v1 = d1 * A; float s = d0 * A + v1;
#define SC_DPP(v_, ctrl_, rm_) __builtin_bit_cast(float, __builtin_amdgcn_update_dpp(0, __builtin_bit_cast(int, v_), ctrl_, rm_, 0xF, true))
    s += SC_DPP(s, 0x111, 0xF); s += SC_DPP(s, 0x112, 0xF); s += SC_DPP(s, 0x114, 0xF); s += SC_DPP(s, 0x118, 0xF);
    s += SC_DPP(s, 0x142, 0xA); s += SC_DPP(s, 0x143, 0xC);
#undef SC_DPP
    s_acum[w * 128 + 2 * lane + 1] = s; s_acum[w * 128 + 2 * lane] = s - v1; s_dt[w * 128 + 2 * lane] = d0; s_dt[w * 128 + 2 * lane + 1] = d1;
}

__device__ __forceinline__ void states_phase(KP p, LAS unsigned char* L) {
    unsigned char* ws = p->ws;
    const bf16* XBC = (const bf16*)(ws + WS_B); const float* DTP = (const float*)(ws + WS_DTP); bf16* ST = (bf16*)(ws + WS_C); float* CD = (float*)(ws + WS_CD);
    LAS float* s_acum = (LAS float*)L; LAS float* s_w = s_acum + 1024; LAS unsigned char* BT = L + 8192; LAS unsigned char* XT = L + 43008;
    const int tid = threadIdx.x, lane = tid & 63, w = __builtin_amdgcn_readfirstlane(tid >> 6), r = lane & 15, q = lane >> 4;
    for (int u = blockIdx.x; u < BATCH * SSD_NC * SSD_G; u += gridDim.x) {
        const int b = u >> 8, c = (u >> 2) & 63, g = u & 3, t0 = b * SEQ + c * 128;
        __syncthreads();
        acum_setup(p, DTP, t0, g, s_acum, s_w);
        __syncthreads();
        for (int i = tid; i < 1024; i += NTHR) s_w[i] = s_w[i] * __expf(s_acum[(i >> 7) * 128 + 127] - s_acum[i]) * (1.f / (LOG2E * LOG2E));
        if (tid < 8) CD[(b * 64 + c) * 32 + g * 8 + tid] = __expf(s_acum[tid * 128 + 127]);
        StageT<256> sx;
        { StageT<128> sb; stage_T_load<128>(XBC, t0, DIN + g * 128, sb); stage_T_load<256>(XBC, t0, g * 512, sx); stage_T_finish<128, false>(p, c == 0, DIN + g * 128, BT, nullptr, sb); }
#pragma unroll
        for (int pass = 0; pass < 2; ++pass) {
            __syncthreads();
            stage_T_finish<256, true>(p, c == 0, g * 512 + pass * 256, XT, s_w + pass * 512, sx);
            if (pass == 0) stage_T_load<256>(XBC, t0, g * 512 + 256, sx);
            __syncthreads();
            const int hl = w >> 1, nh = w & 1;
            f32x4 acc[4][4];
#pragma unroll
            for (int i = 0; i < 4; ++i)
#pragma unroll
                for (int j = 0; j < 4; ++j) acc[i][j] = zero4();
#pragma unroll
            for (int ks = 0; ks < 4; ++ks) {
                bf16x8 bfr[4], xfr[4];
#pragma unroll
                for (int nb = 0; nb < 4; ++nb) bfr[nb] = *(const LAS bf16x8*)(BT + (64 * nh + 16 * nb + r) * PITCH + (32 * ks + 8 * q) * 2);
#pragma unroll
                for (int pb = 0; pb < 4; ++pb) xfr[pb] = *(const LAS bf16x8*)(XT + (64 * hl + 16 * pb + r) * PITCH + (32 * ks + 8 * q) * 2);
#pragma unroll
                for (int pb = 0; pb < 4; ++pb)
#pragma unroll
                    for (int nb = 0; nb < 4; ++nb) acc[pb][nb] = mfma16(bfr[nb], xfr[pb], acc[pb][nb]);
            }
            bf16* base = ST + ((size_t)(b * 64 + c) * 32 + g * 8 + 4 * pass + hl) * 8192;
#pragma unroll
            for (int pb = 0; pb < 4; ++pb)
#pragma unroll
                for (int nb = 0; nb < 4; ++nb) *(v2u*)(base + (16 * pb + r) * 128 + 64 * nh + 16 * nb + 4 * q) = pack4(acc[pb][nb]);
        }
    }
}

__device__ __forceinline__ void scan_phase(KP p) {
    const bf16* ST = (const bf16*)(p->ws + WS_C); bf16* PREV = (bf16*)p->out; const float* CD = (const float*)(p->ws + WS_CD);
    for (int gi = blockIdx.x * NTHR + threadIdx.x; gi < BATCH * SSD_H * SSD_P * 32; gi += gridDim.x * NTHR) {
        const int n4 = gi & 31, pp = (gi >> 5) & 63, h = (gi >> 11) & 31, b = gi >> 16;
        const size_t boff = ((size_t)(b * 64) * 32 + h) * 8192 + pp * 128 + n4 * 4; const bf16* base = ST + boff; bf16* obase = PREV + boff;
        f32x4 run = {0.f, 0.f, 0.f, 0.f};
        for (int c0 = 0; c0 < 64; c0 += 8) {
            v2u ld[8]; float cd[8];
#pragma unroll
            for (int i = 0; i < 8; ++i) { ld[i] = __builtin_nontemporal_load((const v2u*)(base + (size_t)(c0 + i) * 32 * 8192)); cd[i] = CD[(b * 64 + c0 + i) * 32 + h]; }
#pragma unroll
            for (int i = 0; i < 8; ++i) { *(v2u*)(obase + (size_t)(c0 + i) * 32 * 8192) = pack4(run); run = run * cd[i] + unpack4(ld[i]); }
        }
    }
}

template <bool SPLIT> __device__ __forceinline__ void output_phase(KP p, LAS unsigned char* L, const XcdBarrier& bar) {
    unsigned char* ws = p->ws;
    const bf16* XBC = (const bf16*)(ws + WS_B); const float* DTP = (const float*)(ws + WS_DTP); const bf16* ST = (const bf16*)p->out; const bf16* ZS = (const bf16*)(ws + WS_A); bf16* YB = (bf16*)(ws + WS_YB);
    LAS float* s_acum = (LAS float*)L; LAS float* s_dt = s_acum + 1024;
    LAS unsigned char* CN = L + 8192; LAS unsigned char* BN = L + 43008;
    const int tid = threadIdx.x, lane = tid & 63, w = __builtin_amdgcn_readfirstlane(tid >> 6), r = lane & 15, q = lane >> 4;
    LAS unsigned char* MS = L + 77824 + w * (16 * PITCH);
    LAS float* s_tp = (LAS float*)(L + 112640);
    LAS float* s_dk = (LAS float*)(L + 126976);
    LAS float* s_g = (LAS float*)(L + 122880);
    for (int u = blockIdx.x; u < BATCH * SSD_NC * SSD_G; u += gridDim.x) {
        const int b = u >> 8, c = (u >> 2) & 63, g = u & 3, t0 = b * SEQ + c * 128, lrow = 16 * w + r;
        __syncthreads();
        acum_setup(p, DTP, t0, g, s_acum, s_dt);
        stage_N(p, XBC, t0, c == 0, DIN + 512 + g * 128, CN);
        stage_N(p, XBC, t0, c == 0, DIN + g * 128, BN);
        for (int i = lane; i < 16 * PITCH / 16; i += 64) *(LAS v4u*)(MS + i * 16) = (v4u){0u, 0u, 0u, 0u};
        for (int i = tid; i < 5 * 512; i += NTHR) { const int ti = i >> 9, ch = i & 511; s_tp[i] = LOG2E * (ti < 4 ? p->conv_w[ti * CONV_DIM + g * 512 + ch] : p->conv_b[g * 512 + ch]); }
        if (tid < 8) { int t8 = tid; asm volatile("" : "+v"(t8)); s_dk[t8] = p->d_skip[g * 8 + t8]; }
        __syncthreads();
        for (int i = tid; i < 1024; i += NTHR) s_g[i] = __expf(s_acum[(i & ~15) + 15] - s_acum[i]);
        f32x4 cb[8];
#pragma unroll
        for (int sb = 0; sb < 8; ++sb) cb[sb] = zero4();
#pragma unroll
        for (int ks = 0; ks < 4; ++ks) { const bf16x8 cf = *(const LAS bf16x8*)(CN + lrow * PITCH + (32 * ks + 8 * q) * 2);
            bf16x8 bf[8];
#pragma unroll
            for (int sb = 0; sb < 8; ++sb) bf[sb] = *(const LAS bf16x8*)(BN + (16 * sb + r) * PITCH + (32 * ks + 8 * q) * 2);
#pragma unroll
            for (int sb = 0; sb < 8; ++sb) cb[sb] = mfma16(bf[sb], cf, cb[sb]); }
        bf16x8 cfr[4];
#pragma unroll
        for (int ks = 0; ks < 4; ++ks) cfr[ks] = *(const LAS bf16x8*)(CN + lrow * PITCH + (32 * ks + 8 * q) * 2);
        float ss = 0.f;
        const int cp = tid & 31, l0 = (tid >> 5) * 8;
        unsigned xr[11]; v4u pvr[2]; v2u zr[4];
#define S3_LOADS(j_) do { const int hd_ = g * 8 + (j_), ch_ = g * 512 + (j_) * 64 + 2 * cp; \
            _Pragma("unroll") for (int i = 0; i < 11; ++i) xr[i] = *(const unsigned*)(XBC + ((long)(t0 + l0 - 3 + i)) * CONV_DIM + ch_);     \
            { const bf16* src_ = ST + ((size_t)(b * 64 + c) * 32 + hd_) * 8192; _Pragma("unroll") for (int it = 0; it < 2; ++it) { const int idx = tid + it * NTHR; pvr[it] = __builtin_nontemporal_load((const v4u*)(src_ + (idx >> 4) * 128 + (idx & 15) * 8)); } } \
            { const size_t zo_ = (size_t)(t0 + lrow) * DIN + hd_ * 64 + 4 * q; _Pragma("unroll") for (int pb = 0; pb < 4; ++pb) zr[pb] = *(const v2u*)(ZS + zo_ + 16 * pb); } } while (0)
        if (SPLIT && u == (int)blockIdx.x) xcd_barrier_wait(bar);
        S3_LOADS(0);
        __syncthreads();
        for (int j = 0; j < 8; ++j) {
            const int hd = g * 8 + j;
            LAS unsigned char* XT = L + ((j & 1) ? 8192 : 43008); LAS unsigned char* PV = L + ((j & 1) ? 25600 : 60416);
            if (c == 0 && l0 == 0) { xr[0] = 0u; xr[1] = 0u; xr[2] = 0u; }
            { float oa[8], ob[8], tp[10];
#pragma unroll
              for (int i = 0; i < 5; ++i) { const f32x2 tt = *(const LAS f32x2*)(s_tp + i * 512 + j * 64 + 2 * cp); tp[i] = tt[0]; tp[5 + i] = tt[1]; }
#pragma unroll
              for (int i = 0; i < 8; ++i) { const float r0 = __builtin_bit_cast(float, xr[i] << 16), r1 = __builtin_bit_cast(float, xr[i + 1] << 16), r2 = __builtin_bit_cast(float, xr[i + 2] << 16), r3 = __builtin_bit_cast(float, xr[i + 3] << 16);
                  const float q0 = __builtin_bit_cast(float, xr[i] & 0xffff0000u), q1 = __builtin_bit_cast(float, xr[i + 1] & 0xffff0000u), q2 = __builtin_bit_cast(float, xr[i + 2] & 0xffff0000u), q3 = __builtin_bit_cast(float, xr[i + 3] & 0xffff0000u);
                  oa[i] = fsilu2(tp[4] + tp[0] * r0 + tp[1] * r1 + tp[2] * r2 + tp[3] * r3); ob[i] = fsilu2(tp[9] + tp[5] * q0 + tp[6] * q1 + tp[7] * q2 + tp[8] * q3); }
              const LAS float* sc = s_dt + j * 128 + l0; const f32x4 s0 = *(const LAS f32x4*)sc * (1.f / LOG2E), s1 = *(const LAS f32x4*)(sc + 4) * (1.f / LOG2E);
#pragma unroll
              for (int i = 0; i < 4; ++i) { oa[i] *= s0[i]; ob[i] *= s0[i]; oa[4 + i] *= s1[i]; ob[4 + i] *= s1[i]; }
              v4u wa, wb; wa.x = cvtpk(oa[0], oa[1]); wa.y = cvtpk(oa[2], oa[3]); wa.z = cvtpk(oa[4], oa[5]); wa.w = cvtpk(oa[6], oa[7]);
              wb.x = cvtpk(ob[0], ob[1]); wb.y = cvtpk(ob[2], ob[3]); wb.z = cvtpk(ob[4], ob[5]); wb.w = cvtpk(ob[6], ob[7]);
              *(LAS v4u*)(XT + (2 * cp) * PITCH + l0 * 2) = wa; *(LAS v4u*)(XT + (2 * cp + 1) * PITCH + l0 * 2) = wb; }
#pragma unroll
            for (int it = 0; it < 2; ++it) { const int idx = tid + it * NTHR; *(LAS v4u*)(PV + (idx >> 4) * PITCH + (idx & 15) * 16) = pvr[it]; }
            v2u zc[4];
#pragma unroll
            for (int pb = 0; pb < 4; ++pb) zc[pb] = zr[pb];
            const float al = s_acum[j * 128 + lrow], dsk = s_dk[j] / s_dt[j * 128 + lrow];
#pragma unroll
            for (int sb = 0; sb < 8; ++sb) { if (sb <= w) { f32x4 m;
                if (sb < w) { const float F = __expf(al - s_acum[j * 128 + 16 * sb + 15]); m = cb[sb] * F * *(const LAS f32x4*)(s_g + j * 128 + 16 * sb + 4 * q); }
                else { const f32x4 as = *(const LAS f32x4*)(s_acum + j * 128 + 16 * sb + 4 * q);
#pragma unroll
                    for (int i = 0; i < 4; ++i) { const int s = 16 * sb + 4 * q + i; float v = cb[sb][i] * __expf(al - as[i]); if (s > lrow) v = 0.f; if (s == lrow) v += dsk; m[i] = v; } }
                *(LAS v2u*)(MS + r * PITCH + (16 * sb + 4 * q) * 2) = pack4(m); } }
            if (j < 7) S3_LOADS(j + 1);
            __syncthreads();
            f32x4 yd[4], yo[4];
#pragma unroll
            for (int pb = 0; pb < 4; ++pb) { yd[pb] = zero4(); yo[pb] = zero4(); }
#pragma unroll
            for (int ks = 0; ks < 4; ++ks) {
                const bf16x8 cf = cfr[ks];
                bf16x8 pf[4];
#pragma unroll
                for (int pb = 0; pb < 4; ++pb) pf[pb] = *(const LAS bf16x8*)(PV + (16 * pb + r) * PITCH + (32 * ks + 8 * q) * 2);
#pragma unroll
                for (int pb = 0; pb < 4; ++pb) yo[pb] = mfma16(pf[pb], cf, yo[pb]);
                if (2 * ks <= w) { const bf16x8 mf = *(const LAS bf16x8*)(MS + r * PITCH + (32 * ks + 8 * q) * 2);
#pragma unroll
                    for (int pb = 0; pb < 4; ++pb) pf[pb] = *(const LAS bf16x8*)(XT + (16 * pb + r) * PITCH + (32 * ks + 8 * q) * 2);
#pragma unroll
                    for (int pb = 0; pb < 4; ++pb) yd[pb] = mfma16(pf[pb], mf, yd[pb]); }
            }
            const float ea = __expf(al);
            const size_t zoff = (size_t)(t0 + lrow) * DIN + hd * 64 + 16 * q;
            v2u yp[4];
#pragma unroll
            for (int pb = 0; pb < 4; ++pb) { const f32x4 y = (yd[pb] + ea * yo[pb]) * unpack4(zc[pb]); const f32x4 q2 = y * y; ss += (q2[0] + q2[1]) + (q2[2] + q2[3]); yp[pb] = pack4(y); }
            *(v4u*)(YB + zoff) = (v4u){yp[0].x, yp[0].y, yp[1].x, yp[1].y}; *(v4u*)(YB + zoff + 8) = (v4u){yp[2].x, yp[2].y, yp[3].x, yp[3].y};
        }
#undef S3_LOADS
        ss += __shfl_xor(ss, 16); ss += __shfl_xor(ss, 32);
        const float rinv = __builtin_amdgcn_rsqf(ss * (1.f / 512.f) + EPS);
        asm volatile("s_waitcnt vmcnt(0)" ::: "memory");
        { bf16* zb = YB + (size_t)(t0 + lrow) * DIN + g * 512 + 16 * q;
          v4u zv[2][2]; const float rs8 = rinv * YB_SCALE; unsigned char* y8 = ws + WS_YB8 + (size_t)(t0 + lrow) * DIN + g * 512 + 16 * q;
#define S3_NLOAD(j_) do { zv[(j_) & 1][0] = *(const v4u*)(zb + (j_) * 64); zv[(j_) & 1][1] = *(const v4u*)(zb + (j_) * 64 + 8); } while (0)
          S3_NLOAD(0);
#pragma unroll
          for (int j = 0; j < 8; ++j) { if (j < 7) S3_NLOAD(j + 1);
              const v4u za = zv[j & 1][0], zc2 = zv[j & 1][1];
              const f32x4 o0 = unpack4((v2u){za.x, za.y}) * rs8, o1 = unpack4((v2u){za.z, za.w}) * rs8, o2 = unpack4((v2u){zc2.x, zc2.y}) * rs8, o3 = unpack4((v2u){zc2.z, zc2.w}) * rs8;
              *(v4u*)(y8 + j * 64) = (v4u){mk::pk4_fp8(o0[0], o0[1], o0[2], o0[3]), mk::pk4_fp8(o1[0], o1[1], o1[2], o1[3]), mk::pk4_fp8(o2[0], o2[1], o2[2], o2[3]), mk::pk4_fp8(o3[0], o3[1], o3[2], o3[3])}; }
#undef S3_NLOAD
        }
    }
}
}
constexpr int LDS_BYTES = 147456;
constexpr int NPH = 14;
#ifndef MK_ONE_LAUNCH
#define MK_ONE_LAUNCH 1
#endif
constexpr int CW_BAR = 4096;

__global__ void __launch_bounds__(NTHR, 2) k_run(P p_unused) {
    const KP p = (KP)__builtin_amdgcn_kernarg_segment_ptr();
    extern __shared__ __attribute__((aligned(16))) unsigned char lds[];
    volatile LAS unsigned* MISC = (volatile LAS unsigned*)(lds + LDS_BYTES - 64);
    if (threadIdx.x < 16) MISC[threadIdx.x] = 0u;
    __syncthreads();
    XcdBarrier bar; bar.bar = (unsigned*)(p->ws + WS_CTL) + CW_BAR; bar.x = 0; bar.st = nullptr;
    if (MK_ONE_LAUNCH) bar = xcd_barrier_post((unsigned*)(p->ws + WS_CTL) + CW_BAR, MISC + 8);
#define IN(k) (p->ph_lo <= (k) && (k) < p->ph_hi)
#define SEAM(k) do { if (MK_ONE_LAUNCH && IN(k) && IN((k) + 1)) xcd_barrier(bar); } while (0)
    LAS unsigned char* L = (LAS unsigned char*)lds;
    unsigned char* ws = p->ws;
    if (IN(0)) { mk::mod_phase(p, L); __syncthreads(); mk::conv_wdt(p, L); }
    if (MK_ONE_LAUNCH) xcd_barrier_arrive(bar);
    if (IN(0)) { if (!MK_ONE_LAUNCH) mk::rope_phase(p); mk::conv_router(p, L); mk::conv_mixer_weights<0>(p, L); if (!MK_ONE_LAUNCH) { mk::conv_mixer_weights<1>(p, L); mk::conv_mixer_weights<2>(p, L); } }
    if (MK_ONE_LAUNCH) xcd_barrier_wait(bar);
    if (IN(1)) { mk::h_dt_phase(p, L); }
    if (MK_ONE_LAUNCH) { xcd_barrier_arrive(bar); mk::conv_mixer_weights<1>(p, L); xcd_barrier_wait(bar); }
    if (IN(2)) { mk::EpiSsdCols E{ws}; pg8::StaticOrder S; S.init(T, 5120, (int)gridDim.x, (int)blockIdx.x);
                 LAS int* tokl = (LAS int*)(L + mk::LM_OFF + 2048);
                 __syncthreads();
                 for (int i = 0; i < 8; ++i) { pg8::Unit u; if (!S.next(i, u)) break; if (threadIdx.x < 256) tokl[i * 256 + threadIdx.x] = u.pm * 256 + (int)threadIdx.x; }
                 __syncthreads();
                 pg8::Gemm g{(const bf16*)(ws + WS_H8), (const bf16*)(ws + WS_WTIN8), T, 5120, 512};
                 pg8::gemm_phase_gather<mk::EpiSsdCols, pg8::StaticOrder, true>(L, g, S, E, tokl); }
    if (MK_ONE_LAUNCH) { xcd_barrier_arrive(bar); mk::conv_mixer_weights<2>(p, L); xcd_barrier_wait(bar); }
    if (IN(3)) { ssd::states_phase(p, L); }
    if (MK_ONE_LAUNCH) { xcd_barrier_arrive(bar); mk::rope_phase(p); xcd_barrier_wait(bar); }
    if (IN(4)) { ssd::scan_phase(p); }
    if (MK_ONE_LAUNCH) xcd_barrier_arrive(bar);
    if (IN(5)) { ssd::output_phase<MK_ONE_LAUNCH != 0>(p, L, bar); }
    if (MK_ONE_LAUNCH) { xcd_barrier_arrive(bar); if (threadIdx.x == 0) MISC[13] = 1u; }
    if (IN(6)) { mk::EpiAttCols E{ws, p->q_norm_g, p->k_norm_g, (const float*)(ws + WS_ROPE), 0.125f * 1.4426950408889634f, bar, MK_ONE_LAUNCH != 0, (volatile LAS unsigned*)(MISC + 13)};
                 pg8::StaticOrder S; S.init(T, 5120, (int)gridDim.x, (int)blockIdx.x);
                 LAS int* tokl = (LAS int*)(L + mk::LM_OFF + 2048);
                 __syncthreads();
                 for (int i = 0; i < 8; ++i) { pg8::Unit u; if (!S.next(i, u)) break; if (threadIdx.x < 256) tokl[i * 256 + threadIdx.x] = u.pm * 256 + (int)threadIdx.x; }
                 __syncthreads();
                 pg8::Gemm g{(const bf16*)(ws + WS_H8), (const bf16*)(ws + WS_WTIN), T, 5120, 512};
                 pg8::gemm_phase_gather<mk::EpiAttCols, pg8::StaticOrder, true>(L, g, S, E, tokl); } SEAM(6);
    if (IN(7)) { mk::attn_phase(p, lds); }
    if (MK_ONE_LAUNCH) xcd_barrier_arrive(bar);
    if (IN(8)) { mk::EpiMergeF E{(bf16*)(ws + WS_MG), (const bf16*)(ws + WS_GA), (const bf16*)(ws + WS_GB), 1.f / (YB_SCALE * WM_SCALE), bar, MK_ONE_LAUNCH != 0};
                 pg8::StaticOrder S; S.init(T, 1024, (int)gridDim.x, (int)blockIdx.x);
                 LAS int* tokl = (LAS int*)(L + mk::LM_OFF + 2048);
                 __syncthreads();
                 for (int i = 0; i < 8; ++i) { pg8::Unit u; if (!S.next(i, u)) break; if (threadIdx.x < 256) tokl[i * 256 + threadIdx.x] = u.pm * 256 + (int)threadIdx.x; }
                 __syncthreads();
                 pg8::Gemm g1{(const bf16*)(ws + WS_YB8), (const bf16*)(ws + WS_WTB), T, 1024, 1024, (long)WS_YA8 - (long)WS_YB8 - 2048, (long)WS_WTA - (long)WS_WTB - 2048, 16, 24};
                 pg8::gemm_phase_gather<mk::EpiMergeF, pg8::StaticOrder, true, false, true>(L, g1, S, E, tokl); }
    if (MK_ONE_LAUNCH) { xcd_barrier_arrive(bar); if (gridDim.x == 256) mk::conv_expert_slice(p, L, 0); xcd_barrier_wait(bar); }
    if (IN(9)) { mk::EpiMix E{p->out, p->x, (const float*)(ws + WS_MODV)};
                 mk::run_gemm(L, (const bf16*)(ws + WS_MG), (const bf16*)(ws + WS_WTOUT), 1024, 1024, E); }
    { const bool early = MK_ONE_LAUNCH && gridDim.x == 256;
      if (MK_ONE_LAUNCH) xcd_barrier_arrive(bar);
      if (early && IN(10)) { mk::conv_expert_slice(p, L, 4096); mk::conv_expert_weights_q(p, L); }
      if (MK_ONE_LAUNCH) xcd_barrier_wait(bar);
      if (IN(10)) { if (gridDim.x == 256) mk::route_phase3<true>(p, L); else mk::route_phase3<false>(p, L); if (!early) mk::conv_expert_weights_q(p, L); } } SEAM(10);
    if (IN(11)) { mk::moe_up_phase(p, L); }
    if (MK_ONE_LAUNCH) xcd_barrier_arrive(bar);
    if (IN(12)) { mk::moe_down_phase<MK_ONE_LAUNCH != 0>(p, L, bar); }
    if (MK_ONE_LAUNCH) xcd_barrier_arrive(bar);
    if (IN(13)) { mk::final_phase<MK_ONE_LAUNCH != 0>(p, bar); }
#undef IN
#undef SEAM
}

extern "C" void kernel_launch(void* const* d_in, const int* in_sizes, int n_in, void* d_out, int out_size, void* d_ws, size_t ws_size, hipStream_t stream) {
    static int grid = 0;
    if (grid == 0) {
        if (n_in != 29 || out_size != T * DM || ws_size < WS_END) { fprintf(stderr, "kernel_launch: unexpected shapes (n_in %d out %d ws %zu)\n", n_in, out_size, ws_size); grid = -1; return; }
        int dev = 0, cus = 0;
        if (hipGetDevice(&dev) != hipSuccess || hipDeviceGetAttribute(&cus, hipDeviceAttributeMultiprocessorCount, dev) != hipSuccess) { grid = -1; return; }
        if (hipFuncSetAttribute((const void*)k_run, hipFuncAttributeMaxDynamicSharedMemorySize, LDS_BYTES) != hipSuccess) { grid = -1; return; }
        (void)hipGetLastError();
        grid = cus;
    }
    if (grid < 0) return;
    (void)hipMemsetAsync((char*)d_ws + WS_CTL, 0, CTL_ZERO_BYTES, stream);
    P p{};
    const void** pp = (const void**)&p;
    for (int i = 0; i < 29; ++i) pp[i] = d_in[i];
    p.out = (float*)d_out; p.ws = (unsigned char*)d_ws;
    if (MK_ONE_LAUNCH) { p.ph_lo = 0; p.ph_hi = NPH; hipLaunchKernelGGL(k_run, dim3(grid), dim3(NTHR), LDS_BYTES, stream, p); }
    else for (int k = 0; k < NPH; ++k) { p.ph_lo = k; p.ph_hi = k + 1; hipLaunchKernelGGL(k_run, dim3(grid), dim3(NTHR), LDS_BYTES, stream, p); }
}
```
